# Optimizing an MI355X kernel written in HIP

```python
import jax
import jax.numpy as jnp
from jax import lax
import numpy as np

D_MODEL = 1024
BATCH = 8
SEQ = 2048
DEPTH = 1

GRID_W = 64
CTX_LEN = 256
EPS = 1e-6
HG_HEADS = 4
HG_DIM = 128
HG_WIDTH = HG_HEADS * HG_DIM
CHUNK = 32
ATT_HEADS = 8
ATT_KV_HEADS = 2
HEAD_DIM = 64
ATT_WIDTH = ATT_HEADS * HEAD_DIM
KV_WIDTH = ATT_KV_HEADS * HEAD_DIM
WINDOW = 128
BLOCK = 128
ROPE_THETA = 10000.0
D_FF = ((8 * D_MODEL + 3 * 256 - 1) // (3 * 256)) * 256
CTX_COLS = 3 * HG_WIDTH + 2 * KV_WIDTH
IN_COLS = CTX_COLS + 2 * HG_WIDTH + ATT_WIDTH + 2 * D_MODEL

kernel_name = 'hybrid_hgrn2_swa_prefix_dit_block'


def _rmsnorm(x, w):
    xf = x.astype(jnp.float32)
    y = xf * lax.rsqrt(jnp.mean(xf * xf, axis=-1, keepdims=True) + EPS)
    return (y * w.astype(jnp.float32)).astype(x.dtype)


def _modulate(x, w, shift, scale):
    return _rmsnorm(x, w) * (1.0 + scale) + shift


def _heads(t, n_heads, head_dim):
    return t.reshape(t.shape[0], t.shape[1], n_heads, head_dim)


def _split_ctx_side(p):
    a, b, c_, d = HG_WIDTH, 2 * HG_WIDTH, 3 * HG_WIDTH, 3 * HG_WIDTH + KV_WIDTH
    return p[..., :a], p[..., a:b], p[..., b:c_], p[..., c_:d], p[..., d:CTX_COLS]


def _split_query_side(p):
    a = CTX_COLS + HG_WIDTH
    b = a + HG_WIDTH
    c_ = b + ATT_WIDTH
    return p[..., CTX_COLS:a], p[..., a:b], p[..., b:c_], p[..., c_:IN_COLS]


def _gla_chunkwise(q, k, v, log_f, s0):
    b_, s_, h_, dk = k.shape
    dv = v.shape[-1]
    n = s_ // CHUNK

    def chunks(t):
        return t.astype(jnp.float32).reshape(b_, n, CHUNK, h_, t.shape[-1]).transpose(0, 3, 1, 2, 4)

    k, v, log_f = chunks(k), chunks(v), chunks(log_f)
    cum = jnp.cumsum(log_f, axis=3)
    cum_last = cum[:, :, :, -1:, :]
    u = jnp.einsum('bhnck,bhncv->bhnkv', k * jnp.exp(cum_last - cum), v)
    decay = jnp.exp(cum_last[:, :, :, 0, :])

    def step(state, inp):
        d, un = inp
        return d[..., None] * state + un, state

    s_final, s_start = lax.scan(step, s0.astype(jnp.float32),
                                (jnp.moveaxis(decay, 2, 0), jnp.moveaxis(u, 2, 0)))
    if q is None:
        return None, s_final
    s_start = jnp.moveaxis(s_start, 0, 2)
    qd = chunks(q) * jnp.exp(cum)
    scores = jnp.einsum('bhnck,bhnsk->bhncs', qd, k * jnp.exp(-cum))
    lower_tri = jnp.tril(jnp.ones((CHUNK, CHUNK), dtype=bool))
    scores = jnp.where(lower_tri, scores, 0.0)
    o = (jnp.einsum('bhncs,bhnsv->bhncv', scores, v)
         + jnp.einsum('bhnck,bhnkv->bhncv', qd, s_start))
    o = o.transpose(0, 2, 3, 1, 4).reshape(b_, s_, h_, dv)
    return o, s_final


def _hgrn_query(q_raw):
    return _heads(jax.nn.silu(q_raw.astype(jnp.float32)) * HG_DIM ** -0.5, HG_HEADS, HG_DIM)


def _hgrn_direction(q, f_logit, inp, lb, s0, reverse):
    f = lb + (1.0 - lb) * jax.nn.sigmoid(f_logit.astype(jnp.float32))
    log_f = _heads(jnp.log(f), HG_HEADS, HG_DIM)
    k = _heads(1.0 - f, HG_HEADS, HG_DIM)
    v = _heads(inp, HG_HEADS, HG_DIM)
    if reverse:
        q = None if q is None else jnp.flip(q, 1)
        k, v, log_f = jnp.flip(k, 1), jnp.flip(v, 1), jnp.flip(log_f, 1)
    o, s = _gla_chunkwise(q, k, v, log_f, s0)
    if reverse and o is not None:
        o = jnp.flip(o, 1)
    return o, s


def _hgrn_readout(o, g_raw, norm_w, dtype):
    g = _heads(g_raw, HG_HEADS, HG_DIM).astype(jnp.float32)
    y = _rmsnorm(o, norm_w) * jax.nn.silu(g)
    return y.reshape(o.shape[0], o.shape[1], HG_WIDTH).astype(dtype)


def _rope_1d(t, pos):
    d = t.shape[-1]
    inv_freq = ROPE_THETA ** (-jnp.arange(0, d, 2, dtype=jnp.float32) / d)
    ang = pos.astype(jnp.float32)[:, None] * inv_freq[None, :]
    cos = jnp.cos(ang)[None, :, None, :]
    sin = jnp.sin(ang)[None, :, None, :]
    tf = t.astype(jnp.float32)
    t1, t2 = tf[..., : d // 2], tf[..., d // 2:]
    return jnp.concatenate([t1 * cos - t2 * sin, t1 * sin + t2 * cos], axis=-1)


def _axial_rope(t, rows, cols):
    half = t.shape[-1] // 2
    return jnp.concatenate([_rope_1d(t[..., :half], rows), _rope_1d(t[..., half:], cols)],
                           axis=-1).astype(t.dtype)


def _window_attention(q, k, v, kc, vc, sinks):
    b_, s_, hq, dh = q.shape
    hkv = k.shape[2]
    grp = hq // hkv
    nb = s_ // BLOCK
    f32 = jnp.float32
    qb = q.astype(f32).reshape(b_, nb, BLOCK, hkv, grp, dh) * dh ** -0.5

    def band(t):
        tp = jnp.pad(t.astype(f32), ((0, 0), (BLOCK, BLOCK), (0, 0), (0, 0)))
        tp = tp.reshape(b_, nb + 2, BLOCK, hkv, dh)
        return jnp.concatenate([tp[:, :-2], tp[:, 1:-1], tp[:, 2:]], axis=2)

    kw, vw = band(k), band(v)
    s_loc = jnp.einsum('bnqhgd,bnkhd->bnhgqk', qb, kw)
    qi = jnp.arange(BLOCK)[:, None]
    kj = jnp.arange(3 * BLOCK)[None, :]
    k_pos = (jnp.arange(nb)[:, None, None] - 1) * BLOCK + kj[None]
    valid = (jnp.abs(kj - BLOCK - qi) <= WINDOW)[None] & (k_pos >= 0) & (k_pos < s_)
    s_loc = jnp.where(valid[None, :, None, None], s_loc, -jnp.inf)
    s_ctx = jnp.einsum('bnqhgd,blhd->bnhgql', qb, kc.astype(f32))
    sink = jnp.broadcast_to(sinks.astype(f32).reshape(1, 1, hkv, grp, 1, 1), s_loc.shape[:-1] + (1,))
    p = jax.nn.softmax(jnp.concatenate([s_loc, s_ctx, sink], axis=-1), axis=-1)
    n_loc = 3 * BLOCK
    n_ctx = kc.shape[1]
    o = (jnp.einsum('bnhgqk,bnkhd->bnqhgd', p[..., :n_loc], vw)
         + jnp.einsum('bnhgql,blhd->bnqhgd', p[..., n_loc:n_loc + n_ctx], vc.astype(f32)))
    return o.reshape(b_, s_, hq * dh).astype(v.dtype)


def _context_attention(qc, kc, vc, sinks):
    b_, l_, hq, dh = qc.shape
    hkv = kc.shape[2]
    grp = hq // hkv
    f32 = jnp.float32
    qg = qc.astype(f32).reshape(b_, l_, hkv, grp, dh) * dh ** -0.5
    s = jnp.einsum('blhgd,bmhd->bhglm', qg, kc.astype(f32))
    sink = jnp.broadcast_to(sinks.astype(f32).reshape(1, hkv, grp, 1, 1), s.shape[:-1] + (1,))
    p = jax.nn.softmax(jnp.concatenate([s, sink], axis=-1), axis=-1)
    o = jnp.einsum('bhglm,bmhd->blhgd', p[..., :l_], vc.astype(f32))
    return o.reshape(b_, l_, hq * dh).astype(vc.dtype)


def _merge(y_hg, y_at, gates, w_bh, w_ba, w_o):
    g_hg, g_at = jnp.split(gates, 2, axis=-1)
    mixed = jax.nn.sigmoid(g_hg) * (y_hg @ w_bh) + jax.nn.sigmoid(g_at) * (y_at @ w_ba)
    return mixed @ w_o


def _swiglu(h, w_gate, w_up, w_down):
    return (jax.nn.silu(h @ w_gate) * (h @ w_up)) @ w_down


def setup_inputs(seed: int = 0) -> dict:
    key = jax.random.key(seed)
    ks = jax.random.split(key, 20)
    f32 = jnp.float32

    def nrm(k, shape, scale):
        return jax.random.normal(k, shape, f32) * scale

    return {
        'x': nrm(ks[0], (BATCH, SEQ, D_MODEL), 1.0),
        'c': nrm(ks[1], (BATCH, D_MODEL), 1.0),
        'ctx': nrm(ks[2], (BATCH, CTX_LEN, D_MODEL), 1.0),
        'c_ctx': nrm(ks[3], (D_MODEL,), 1.0),
        'w_ada': nrm(ks[4], (DEPTH, D_MODEL, 6 * D_MODEL), 0.5 * D_MODEL ** -0.5),
        'b_ada': nrm(ks[5], (DEPTH, 6 * D_MODEL), 0.02),
        'norm_mix_w': 1.0 + nrm(ks[6], (DEPTH, D_MODEL), 0.02),
        'norm_ffn_w': 1.0 + nrm(ks[7], (DEPTH, D_MODEL), 0.02),
        'w_in': nrm(ks[8], (DEPTH, D_MODEL, IN_COLS), D_MODEL ** -0.5),
        'hgrn_lb_logits': nrm(ks[9], (2, DEPTH + 1, HG_WIDTH), 0.5),
        'hgrn_norm_w': 1.0 + nrm(ks[10], (DEPTH, HG_DIM), 0.02),
        'q_norm_w': 1.0 + nrm(ks[11], (DEPTH, HEAD_DIM), 0.02),
        'k_norm_w': 1.0 + nrm(ks[12], (DEPTH, HEAD_DIM), 0.02),
        'attn_sinks': nrm(ks[13], (DEPTH, ATT_HEADS), 0.5),
        'w_branch_hgrn': nrm(ks[14], (DEPTH, HG_WIDTH, D_MODEL), HG_WIDTH ** -0.5),
        'w_branch_attn': nrm(ks[15], (DEPTH, ATT_WIDTH, D_MODEL), ATT_WIDTH ** -0.5),
        'w_out': nrm(ks[16], (DEPTH, D_MODEL, D_MODEL), D_MODEL ** -0.5),
        'w_ffn_gate': nrm(ks[17], (DEPTH, D_MODEL, D_FF), D_MODEL ** -0.5),
        'w_ffn_up': nrm(ks[18], (DEPTH, D_MODEL, D_FF), D_MODEL ** -0.5),
        'w_ffn_down': nrm(ks[19], (DEPTH, D_FF, D_MODEL), D_FF ** -0.5),
    }


def reference(x, c, ctx, c_ctx, w_ada, b_ada, norm_mix_w, norm_ffn_w, w_in, hgrn_lb_logits,
              hgrn_norm_w, q_norm_w, k_norm_w, attn_sinks, w_branch_hgrn, w_branch_attn,
              w_out, w_ffn_gate, w_ffn_up, w_ffn_down):
    n_lat = x.shape[1]
    ROWS = n_lat // GRID_W
    rows = jnp.repeat(jnp.arange(ROWS), GRID_W)
    cols = jnp.tile(jnp.arange(GRID_W), ROWS)
    lower_bounds = jnp.cumsum(jax.nn.softmax(hgrn_lb_logits.astype(jnp.float32), axis=1), axis=1)

    for layer in range(DEPTH):
        last = layer == DEPTH - 1
        mod = jax.nn.silu(c) @ w_ada[layer] + b_ada[layer]
        mod_c = jax.nn.silu(c_ctx) @ w_ada[layer] + b_ada[layer]
        sh1, sc1, g1, sh2, sc2, g2 = [m[:, None, :] for m in jnp.split(mod, 6, axis=-1)]
        csh1, csc1, cg1, csh2, csc2, cg2 = jnp.split(mod_c, 6, axis=-1)
        lb_fwd, lb_bwd = lower_bounds[0, layer], lower_bounds[1, layer]

        h = _modulate(x, norm_mix_w[layer], sh1, sc1)
        hc = _modulate(ctx, norm_mix_w[layer], csh1, csc1)
        p = h @ w_in[layer]
        pc = hc @ (w_in[layer, :, :CTX_COLS] if last else w_in[layer])

        cf_fwd, cf_bwd, c_inp, c_k, c_v = _split_ctx_side(pc)
        s0 = jnp.zeros((ctx.shape[0], HG_HEADS, HG_DIM, HG_DIM), jnp.float32)
        c_q_hg = None if last else _hgrn_query(_split_query_side(pc)[0])
        co_fwd, cs_fwd = _hgrn_direction(c_q_hg, cf_fwd, c_inp, lb_fwd, s0, False)
        co_bwd, cs_bwd = _hgrn_direction(c_q_hg, cf_bwd, c_inp, lb_bwd, s0, True)
        ck = _rmsnorm(_heads(c_k, ATT_KV_HEADS, HEAD_DIM), k_norm_w[layer])
        cv = _heads(c_v, ATT_KV_HEADS, HEAD_DIM)

        f_fwd, f_bwd, inp, k_raw, v_raw = _split_ctx_side(p)
        q_hg_raw, g_hg, q_raw, gates = _split_query_side(p)
        q_hg = _hgrn_query(q_hg_raw)
        o_fwd, _ = _hgrn_direction(q_hg, f_fwd, inp, lb_fwd, cs_fwd, False)
        o_bwd, _ = _hgrn_direction(q_hg, f_bwd, inp, lb_bwd, cs_bwd, True)
        y_hg = _hgrn_readout(o_fwd + o_bwd, g_hg, hgrn_norm_w[layer], x.dtype)
        q = _axial_rope(_rmsnorm(_heads(q_raw, ATT_HEADS, HEAD_DIM), q_norm_w[layer]), rows, cols)
        k = _axial_rope(_rmsnorm(_heads(k_raw, ATT_KV_HEADS, HEAD_DIM), k_norm_w[layer]), rows, cols)
        y_at = _window_attention(q, k, _heads(v_raw, ATT_KV_HEADS, HEAD_DIM), ck, cv, attn_sinks[layer])
        x_new = x + g1 * _merge(y_hg, y_at, gates, w_branch_hgrn[layer], w_branch_attn[layer], w_out[layer])
        x_new = x_new + g2 * _swiglu(_modulate(x_new, norm_ffn_w[layer], sh2, sc2),
                                     w_ffn_gate[layer], w_ffn_up[layer], w_ffn_down[layer])

        if not last:
            _, cg_hg, cq_raw, c_gates = _split_query_side(pc)
            cy_hg = _hgrn_readout(co_fwd + co_bwd, cg_hg, hgrn_norm_w[layer], ctx.dtype)
            cq = _rmsnorm(_heads(cq_raw, ATT_HEADS, HEAD_DIM), q_norm_w[layer])
            cy_at = _context_attention(cq, ck, cv, attn_sinks[layer])
            ctx = ctx + cg1 * _merge(cy_hg, cy_at, c_gates, w_branch_hgrn[layer],
                                     w_branch_attn[layer], w_out[layer])
            ctx = ctx + cg2 * _swiglu(_modulate(ctx, norm_ffn_w[layer], csh2, csc2),
                                      w_ffn_gate[layer], w_ffn_up[layer], w_ffn_down[layer])
        x = x_new
    return x
```

```cpp
#include <hip/hip_runtime.h>
#include <hip/hip_cooperative_groups.h>
#include <cstdio>
#include <cstdint>
namespace cg = cooperative_groups;

#ifndef COOP
#define COOP 1
#endif
#ifndef PROBE_MASK
#define PROBE_MASK 0
#define PROBE_N 1
#endif
#ifndef HGRN_FAST
#define HGRN_FAST 1
#endif
#ifndef ATTN_FAST
#define ATTN_FAST 1
#endif

#define LAS __attribute__((address_space(3)))
typedef unsigned short bf16_t;
typedef short bf16x8 __attribute__((ext_vector_type(8)));
typedef float f32x4 __attribute__((ext_vector_type(4)));
typedef unsigned u32x4 __attribute__((ext_vector_type(4)));
typedef unsigned u32x2 __attribute__((ext_vector_type(2)));

constexpr int MLAT = 16384, MALL = 18432;
constexpr float EPSN = 1e-6f;
constexpr int LDS_WORK = 154624, LDS_BYTES = LDS_WORK + 16;

constexpr size_t OFF_WIN = 0;
constexpr size_t OFF_WB = OFF_WIN + (size_t)5376 * 1024 * 2;
constexpr size_t OFF_WOUT = OFF_WB + (size_t)2048 * 512 * 2;
constexpr size_t OFF_WGU = OFF_WOUT + (size_t)1024 * 1024 * 2;
constexpr size_t OFF_WDN = OFF_WGU + (size_t)5632 * 1024 * 2;
constexpr size_t OFF_MOD = OFF_WDN + (size_t)1024 * 2816 * 2;
constexpr size_t OFF_TAB = OFF_MOD + (size_t)9 * 6144 * 4;
constexpr size_t OFF_LF = OFF_TAB + 12288;
constexpr size_t OFF_INP = OFF_LF + (size_t)MALL * 1024 * 4;
constexpr size_t OFF_KV = OFF_INP + (size_t)MALL * 512 * 2;
constexpr size_t OFF_QHG = OFF_KV + (size_t)MALL * 256 * 2;
constexpr size_t OFF_GHG = OFF_QHG + (size_t)MLAT * 512 * 2;
constexpr size_t OFF_QAT = OFF_GHG + (size_t)MLAT * 512 * 2;
constexpr size_t OFF_GATES = OFF_QAT + (size_t)MLAT * 512 * 2;
constexpr size_t OFF_BAR = OFF_GATES + (size_t)MLAT * 2048 * 2;
constexpr size_t BAR_BYTES = 3456 * 4;
constexpr size_t WS_END = OFF_BAR + BAR_BYTES;
constexpr size_t OFF_MIXED = OFF_LF;
constexpr size_t OFF_H2 = OFF_LF + (size_t)MLAT * 1024 * 2;
constexpr size_t OFF_ACT = OFF_INP;
constexpr size_t OUT_OF = (size_t)MLAT * 1024 * 2, OUT_OB = OUT_OF + (size_t)MLAT * 512 * 2;

struct Params {
    const float *x, *c, *ctx, *c_ctx, *w_ada, *b_ada, *norm_mix_w, *norm_ffn_w, *w_in, *lb_logits, *hgrn_norm_w, *q_norm_w, *k_norm_w, *sinks, *w_bh, *w_ba, *w_out, *w_gate, *w_up, *w_dn;
    float* out; unsigned char* ws;
};

__device__ __forceinline__ int tid_() { int t = threadIdx.x; asm volatile("" : "+v"(t)); return t; }
typedef float f32x2_t __attribute__((ext_vector_type(2)));
typedef __bf16 bf16x2_t __attribute__((ext_vector_type(2)));
typedef float f32x16 __attribute__((ext_vector_type(16)));
typedef _Float16 half_t;
typedef _Float16 half2_t __attribute__((ext_vector_type(2)));
__device__ __forceinline__ unsigned cvt_pk_f16(float lo, float hi) { const f32x2_t v = {lo, hi}; return __builtin_bit_cast(unsigned, __builtin_convertvector(v, half2_t)); }
__device__ __forceinline__ unsigned cvt_pk_bf16(float lo, float hi) { const f32x2_t v = {lo, hi}; return __builtin_bit_cast(unsigned, __builtin_convertvector(v, bf16x2_t)); }
__device__ __forceinline__ float bf_lo(unsigned u) { return __uint_as_float(u << 16); }
__device__ __forceinline__ float bf_hi(unsigned u) { return __uint_as_float(u & 0xffff0000u); }
__device__ __forceinline__ float bf2f(bf16_t b) { return __uint_as_float(((unsigned)b) << 16); }
__device__ __forceinline__ bf16_t f2bf(float f) { return (bf16_t)(cvt_pk_bf16(f, 0.f) & 0xffffu); }
__device__ __forceinline__ float sigm(float z) { return __builtin_amdgcn_rcpf(1.f + __expf(-z)); }
__device__ __forceinline__ u32x4 pack8(const f32x4 a, const f32x4 b) { u32x4 w; w.x = cvt_pk_bf16(a[0], a[1]); w.y = cvt_pk_bf16(a[2], a[3]); w.z = cvt_pk_bf16(b[0], b[1]); w.w = cvt_pk_bf16(b[2], b[3]); return w; }

namespace pg8 {
constexpr int BM = 256, BK = 64, HALF = 128, HTB = HALF * BK * 2, STAGE_BYTES = 8 * HTB, NXCD = 8, WGM = 8;
__host__ __device__ __forceinline__ int lds_byte(int r, int c) { const int st = (r >> 4) * 2 + (c >> 5), rr = r & 15, cc = c & 31, ob = rr * 64 + cc * 2; return st * 1024 + (ob ^ (((ob >> 9) & 1) << 5)); }
__host__ __device__ __forceinline__ void stage_rc(int b, int& R, int& C) { const int st = b / 1024, sb = b % 1024, swz = sb ^ (((sb >> 9) & 1) << 5); R = (st >> 1) * 16 + swz / 64; C = (st & 1) * 32 + (swz % 64) / 2; }
__host__ __device__ __forceinline__ int perm32(int rho) { const int n = rho >> 4, i = rho & 15; return 8 * (i >> 2) + 4 * n + (i & 3); }
struct Unit { int pm, pn; };
struct Gemm { const bf16_t* A; const bf16_t* Bt; int K; };

__device__ __forceinline__ void static_map(int L, int nM, int nN, Unit& u) {
    const int nwg = nM * nN; int wgid = L;
    { const int q = nwg / NXCD, r = nwg % NXCD, xcd = wgid % NXCD, off = wgid / NXCD; wgid = (xcd < r ? xcd * (q + 1) : r * (q + 1) + (xcd - r) * q) + off; }
    const int nig = WGM * nN, gid = wgid / nig, fm = gid * WGM, gsz = (nM - fm) < WGM ? (nM - fm) : WGM;
    u.pm = fm + ((wgid % nig) % gsz); u.pn = (wgid % nig) / gsz;
}

template <class Epi, class Sched, bool ALIGN_EPI, bool SP2>
__device__ __forceinline__ void gemm_phase(LAS unsigned char* lds, const Gemm g, const Sched& S, const Epi& E) {
    const int tid = tid_(), wid = __builtin_amdgcn_readfirstlane(tid >> 6), lane = tid & 63, wr = wid >> 2, wc = wid & 3, fr = lane & 15, fq = lane >> 4;
    int K_ = g.K; asm volatile("" : "+s"(K_)); const int K = K_, nt = K / BK;
    unsigned voffA[2], voffB[2];
#pragma unroll
    for (int i = 0; i < 2; ++i) { int R, C; stage_rc(tid * 16 + i * 8192, R, C); const int Rb = Epi::PERM ? ((R & ~31) + perm32(R & 31)) : R;
        voffA[i] = (unsigned)(R * K + C) * 2u; voffB[i] = (unsigned)(Rb * K + C) * 2u; }
    const size_t kstep = (size_t)(BK * 2);
    const size_t hstep = (size_t)HALF * K * 2;
    const size_t tstep = 2 * hstep;
    const unsigned ldsw = (unsigned)wid * 1024u;
    const int aoff = lds_byte(wr * 64 + fr, fq * 8), boff = lds_byte(wc * 32 + fr, fq * 8);
#define PG8_SA(b, h) (((b) * 2 + (h)) * HTB)
#define PG8_SB(b, h) ((4 + (b) * 2 + (h)) * HTB)
#define PG8_STAGE(bufoff, gbase, voff) do { _Pragma("unroll") for (int _i = 0; _i < 2; ++_i) \
        __builtin_amdgcn_global_load_lds((const unsigned*)((const char*)(gbase) + (voff)[_i]), (LAS unsigned*)(lds + (bufoff) + ldsw + _i * 8192), 16, 0, 0); } while (0)
#define PG8_LDA(dst, b, h) do { _Pragma("unroll") for (int m = 0; m < 4; ++m) _Pragma("unroll") for (int k = 0; k < 2; ++k) dst[m][k] = *(const LAS bf16x8*)(lds + PG8_SA(b, h) + aoff + m * 2048 + k * 1024); } while (0)
#define PG8_LDB(dst, b, h) do { _Pragma("unroll") for (int n = 0; n < 2; ++n) _Pragma("unroll") for (int k = 0; k < 2; ++k) dst[n][k] = *(const LAS bf16x8*)(lds + PG8_SB(b, h) + boff + n * 2048 + k * 1024); } while (0)
#define PG8_MMA(ai, bj, At, Bt) do { __builtin_amdgcn_s_setprio(1); _Pragma("unroll") for (int m = 0; m < 4; ++m) _Pragma("unroll") for (int n = 0; n < 2; ++n) _Pragma("unroll") for (int k = 0; k < 2; ++k) \
        acc[ai][bj][m][n] = __builtin_amdgcn_mfma_f32_16x16x32_bf16(Bt[n][k], At[m][k], acc[ai][bj][m][n], 0, 0, 0); __builtin_amdgcn_s_setprio(0); } while (0)
#define PG8_WAIT_V(n) asm volatile("s_waitcnt vmcnt(" #n ")" ::: "memory")
#define PG8_WAIT_L(n) asm volatile("s_waitcnt lgkmcnt(" #n ")" ::: "memory")
#define PG8_BAR __builtin_amdgcn_s_barrier()
#define PG8_SCHED __builtin_amdgcn_sched_barrier(0)
    Unit cur, nxt; int ui = 0;
    if (!S.next(0, cur)) return;
    f32x4 acc[2][2][4][2];
#pragma unroll
    for (int a = 0; a < 2; ++a)
#pragma unroll
        for (int b = 0; b < 2; ++b)
#pragma unroll
            for (int m = 0; m < 4; ++m)
#pragma unroll
                for (int n = 0; n < 2; ++n) acc[a][b][m][n] = (f32x4){0.f, 0.f, 0.f, 0.f};
    bf16x8 At[4][2], B0[2][2], B1[2][2];
    const char* cA = (const char*)g.A + (size_t)cur.pm * tstep; const char* cB = (const char*)g.Bt + (size_t)cur.pn * tstep;
    if constexpr (SP2) {
        PG8_STAGE(PG8_SB(0, 0), cB, voffB); PG8_STAGE(PG8_SB(0, 1), cB + hstep, voffB); PG8_STAGE(PG8_SA(0, 0), cA, voffA); PG8_STAGE(PG8_SA(0, 1), cA + hstep, voffA);
        if (wr == 1) PG8_BAR;
        PG8_WAIT_V(2); PG8_BAR;
        PG8_STAGE(PG8_SB(1, 0), cB + kstep, voffB); PG8_STAGE(PG8_SA(1, 0), cA + kstep, voffA); PG8_STAGE(PG8_SB(1, 1), cB + hstep + kstep, voffB);
        PG8_WAIT_V(6); PG8_BAR;
    } else {
        PG8_STAGE(PG8_SB(0, 0), cB, voffB); PG8_STAGE(PG8_SA(0, 0), cA, voffA); PG8_STAGE(PG8_SB(0, 1), cB + hstep, voffB); PG8_STAGE(PG8_SA(0, 1), cA + hstep, voffA);
        if (wr == 1) PG8_BAR;
        PG8_WAIT_V(4); PG8_BAR;
        PG8_STAGE(PG8_SB(1, 0), cB + kstep, voffB); PG8_STAGE(PG8_SA(1, 0), cA + kstep, voffA); PG8_STAGE(PG8_SB(1, 1), cB + hstep + kstep, voffB);
        PG8_WAIT_V(6); PG8_BAR;
    }
    for (;;) {
        const bool has_next = S.next(ui + 1, nxt);
        const char* nA = has_next ? (const char*)g.A + (size_t)nxt.pm * tstep : cA; const char* nB = has_next ? (const char*)g.Bt + (size_t)nxt.pn * tstep : cB;
#pragma unroll 1
        for (int t = 0; t < nt; t += 2) {
            const bool last = (t == nt - 2);
            const char* a1 = cA + (size_t)(t + 1) * kstep;
            const char* a2 = last ? nA : cA + (size_t)(t + 2) * kstep; const char* b2 = last ? nB : cB + (size_t)(t + 2) * kstep;
            const char* a3 = a2 + kstep; const char* b3 = b2 + kstep;
            if constexpr (SP2) {
            PG8_LDB(B0, 0, 0); PG8_LDB(B1, 0, 1); PG8_SCHED; PG8_LDA(At, 0, 0); PG8_STAGE(PG8_SA(1, 1), a1 + hstep, voffA);
            PG8_WAIT_V(8); PG8_WAIT_L(0); PG8_BAR; PG8_MMA(0, 0, At, B0); PG8_MMA(0, 1, At, B1); PG8_BAR; PG8_SCHED;
            PG8_LDA(At, 0, 1); PG8_STAGE(PG8_SB(0, 0), b2, voffB); PG8_STAGE(PG8_SB(0, 1), b2 + hstep, voffB); PG8_STAGE(PG8_SA(0, 0), a2, voffA);
            PG8_WAIT_V(8); PG8_WAIT_L(0); PG8_BAR; PG8_MMA(1, 0, At, B0); PG8_MMA(1, 1, At, B1); PG8_BAR; PG8_SCHED;
            PG8_LDB(B0, 1, 0); PG8_LDB(B1, 1, 1); PG8_SCHED; PG8_LDA(At, 1, 0); PG8_STAGE(PG8_SA(0, 1), a2 + hstep, voffA);
            PG8_WAIT_V(8); PG8_WAIT_L(0); PG8_BAR; PG8_MMA(0, 0, At, B0); PG8_MMA(0, 1, At, B1); PG8_BAR; PG8_SCHED;
            PG8_LDA(At, 1, 1); PG8_STAGE(PG8_SB(1, 0), b3, voffB); PG8_STAGE(PG8_SB(1, 1), b3 + hstep, voffB); PG8_STAGE(PG8_SA(1, 0), a3, voffA);
            PG8_WAIT_V(8); PG8_WAIT_L(0); PG8_BAR; PG8_MMA(1, 0, At, B0); PG8_MMA(1, 1, At, B1); PG8_BAR; PG8_SCHED;
            } else {
            PG8_LDB(B0, 0, 0); PG8_SCHED; PG8_LDA(At, 0, 0); PG8_STAGE(PG8_SA(1, 1), a1 + hstep, voffA);
            PG8_WAIT_L(8); PG8_BAR; PG8_WAIT_L(0); PG8_MMA(0, 0, At, B0); PG8_BAR; PG8_SCHED;
            PG8_LDB(B1, 0, 1); PG8_STAGE(PG8_SB(0, 0), b2, voffB);
            PG8_BAR; PG8_WAIT_L(0); PG8_MMA(0, 1, At, B1); PG8_BAR;
            PG8_LDA(At, 0, 1); PG8_STAGE(PG8_SA(0, 0), a2, voffA);
            PG8_BAR; PG8_WAIT_L(0); PG8_MMA(1, 0, At, B0); PG8_BAR; PG8_SCHED;
            PG8_STAGE(PG8_SB(0, 1), b2 + hstep, voffB);
            PG8_WAIT_V(6); PG8_BAR; PG8_MMA(1, 1, At, B1); PG8_BAR;
            PG8_LDB(B0, 1, 0); PG8_SCHED; PG8_LDA(At, 1, 0); PG8_STAGE(PG8_SA(0, 1), a2 + hstep, voffA);
            PG8_WAIT_L(8); PG8_BAR; PG8_WAIT_L(0); PG8_MMA(0, 0, At, B0); PG8_BAR; PG8_SCHED;
            PG8_LDB(B1, 1, 1); PG8_STAGE(PG8_SB(1, 0), b3, voffB);
            PG8_BAR; PG8_WAIT_L(0); PG8_MMA(0, 1, At, B1); PG8_BAR;
            PG8_LDA(At, 1, 1); PG8_STAGE(PG8_SA(1, 0), a3, voffA);
            PG8_BAR; PG8_WAIT_L(0); PG8_MMA(1, 0, At, B0); PG8_BAR; PG8_SCHED;
            PG8_STAGE(PG8_SB(1, 1), b3 + hstep, voffB);
            PG8_WAIT_V(6); PG8_BAR; PG8_MMA(1, 1, At, B1); PG8_BAR;
            }
        }
        if constexpr (ALIGN_EPI) { if (wr == 0) PG8_BAR; }
        { int fr_ = fr, fq_ = fq; asm volatile("" : "+v"(fr_), "+v"(fq_)); E(acc, cur, wr, wc, fr_, fq_); }
        if (!has_next) break;
        if (E.zero_after(cur)) {
#pragma unroll
        for (int a = 0; a < 2; ++a)
#pragma unroll
            for (int b = 0; b < 2; ++b)
#pragma unroll
                for (int m = 0; m < 4; ++m)
#pragma unroll
                    for (int n = 0; n < 2; ++n) acc[a][b][m][n] = (f32x4){0.f, 0.f, 0.f, 0.f};
        }
        cur = nxt; cA = nA; cB = nB; ++ui;
        if constexpr (ALIGN_EPI) { if (wr == 1) PG8_BAR; }
    }
    PG8_WAIT_V(0);
    if constexpr (!ALIGN_EPI) { if (wr == 0) PG8_BAR; }
    PG8_BAR;
#undef PG8_SA
#undef PG8_SB
#undef PG8_STAGE
#undef PG8_LDA
#undef PG8_LDB
#undef PG8_MMA
#undef PG8_WAIT_V
#undef PG8_WAIT_L
#undef PG8_BAR
#undef PG8_SCHED
}
}
using pg8::Unit;

struct SchedPlain { int nM, nN, G, c;
    __device__ __forceinline__ bool next(int i, Unit& u) const { const long L = (long)i * G + c; if (L >= (long)nM * nN) return false; pg8::static_map((int)L, nM, nN, u); return true; } };
struct SchedIn { int G, c;
    __device__ __forceinline__ bool next(int i, Unit& u) const { const long L = (long)i * G + c; if (L >= 1400) return false;
        if (L < 1344) pg8::static_map((int)L, 64, 21, u); else { const int e = (int)L - 1344; u.pm = 64 + (e & 7); u.pn = e >> 3; } return true; } };
struct SchedInA { int G, c;
    __device__ __forceinline__ bool next(int i, Unit& u) const { const long L = (long)i * G + c; if (L >= 760) return false;
        if (L < 704) { pg8::static_map((int)L, 64, 11, u); u.pn = u.pn < 9 ? u.pn : u.pn + 2; } else { const int e = (int)L - 704; u.pm = 64 + (e & 7); u.pn = e >> 3; } return true; } };
struct SchedInB { int G, c;
    __device__ __forceinline__ bool next(int i, Unit& u) const { const long L = (long)i * G + c; if (L >= 640) return false;
        pg8::static_map((int)L, 64, 10, u); u.pn = u.pn < 2 ? u.pn + 9 : u.pn + 11; return true; } };
struct SchedPair { int G, c;
    __device__ __forceinline__ bool next(int i, Unit& u) const { const long L = (long)(i >> 1) * G + c; if (L >= 256) return false; pg8::static_map((int)L, 64, 4, u); if (i & 1) { u.pm += 64; u.pn += 4; } return true; } };

__host__ __device__ __forceinline__ int in_src_col(int n) {
    const int pn = n >> 8, pc = n & 255;
    if (pn == 6 || pn == 11 || pn == 12) {
        const int bj = pc >> 7, wc = (pc >> 5) & 3, fq = (pc >> 3) & 3, nn = (pc >> 2) & 1, j = pc & 3;
        if (pn == 6) { if (wc < 2) return 1536 + 64 * wc + 32 * bj + 16 * nn + 4 * fq + j; return 1664 + 64 * (wc - 2) + 32 * bj + 8 * fq + 4 * nn + j; }
        return 2816 + 64 * (4 * (pn - 11) + wc) + 32 * bj + 16 * nn + 4 * fq + j;
    }
    if (pn >= 13) return 3328 + (((n & 255) >> 7) ? 1024 : 0) + 128 * (pn - 13) + (n & 127);
    return n;
}

struct EpiIn {
    static constexpr bool PERM = true;
    half_t* lf; bf16_t *inp, *kv, *qhg, *ghg, *qat, *gates; const float *lbt, *rcos, *rsin, *qnw, *knw;
    __device__ __forceinline__ bool zero_after(const Unit&) const { return true; }
    __device__ __forceinline__ void head_norm_rope(f32x4 (&acc)[2][2][4][2], int ai, int m, int row, int fq, const float* nw, bool rope, float scale, bf16_t* dst) const {
        float ss = 0.f;
#pragma unroll
        for (int bj = 0; bj < 2; ++bj)
#pragma unroll
            for (int n = 0; n < 2; ++n) { const f32x4 v = acc[ai][bj][m][n]; ss += (v[0] * v[0] + v[1] * v[1]) + (v[2] * v[2] + v[3] * v[3]); }
        ss += __shfl_xor(ss, 16); ss += __shfl_xor(ss, 32);
        const float rinv = rsqrtf(ss * (1.f / 64.f) + EPSN) * scale;
        const int t = row & 2047;
#pragma unroll
        for (int bj = 0; bj < 2; ++bj) {
            const int pos = bj ? (t & 63) : (t >> 6);
            const f32x4 w0 = *(const f32x4*)(nw + 32 * bj + 4 * fq), w1 = *(const f32x4*)(nw + 32 * bj + 16 + 4 * fq);
            const f32x4 t1 = acc[ai][bj][m][0] * rinv * w0, t2 = acc[ai][bj][m][1] * rinv * w1;
            f32x4 o1 = t1, o2 = t2;
            if (rope) { const f32x4 cs = *(const f32x4*)(rcos + pos * 16 + 4 * fq), sn = *(const f32x4*)(rsin + pos * 16 + 4 * fq); o1 = t1 * cs - t2 * sn; o2 = t1 * sn + t2 * cs; }
            *(u32x4*)(dst + 32 * bj + 8 * fq) = pack8(o1, o2);
        }
    }
    __device__ __forceinline__ void operator()(f32x4 (&acc)[2][2][4][2], const Unit& u, int wr, int wc, int fr, int fq) const {
        const int pn = u.pn, rbase = u.pm * 256 + wr * 64 + fr;
        if (pn < 4) {
#pragma unroll
            for (int bj = 0; bj < 2; ++bj) {
                const int col = pn * 256 + bj * 128 + wc * 32 + 8 * fq;
                const f32x4 lb0 = *(const f32x4*)(lbt + col), lb1 = *(const f32x4*)(lbt + col + 4);
#pragma unroll
                for (int ai = 0; ai < 2; ++ai)
#pragma unroll
                    for (int m = 0; m < 4; ++m) {
                        const int row = rbase + ai * 128 + m * 16; const f32x4 v0 = acc[ai][bj][m][0], v1 = acc[ai][bj][m][1]; f32x4 o0, o1;
#pragma unroll
                        for (int j = 0; j < 4; ++j) { o0[j] = __builtin_amdgcn_logf(lb0[j] + (1.f - lb0[j]) * sigm(v0[j])); o1[j] = __builtin_amdgcn_logf(lb1[j] + (1.f - lb1[j]) * sigm(v1[j])); }
                        u32x4 hw; hw.x = cvt_pk_f16(o0[0], o0[1]); hw.y = cvt_pk_f16(o0[2], o0[3]); hw.z = cvt_pk_f16(o1[0], o1[1]); hw.w = cvt_pk_f16(o1[2], o1[3]); *(u32x4*)(lf + ((((size_t)(row >> 5) * 8 + (col >> 7)) * 32 + (row & 31)) * 128 + (col & 127))) = hw;
                    }
            }
        } else if (pn == 6) {
#pragma unroll
            for (int ai = 0; ai < 2; ++ai)
#pragma unroll
                for (int m = 0; m < 4; ++m) {
                    const int row = rbase + ai * 128 + m * 16; bf16_t* d = kv + (size_t)row * 256 + wc * 64;
                    if (wc < 2) head_norm_rope(acc, ai, m, row, fq, knw, u.pm < 64, 1.f, d);
                    else {
#pragma unroll
                        for (int bj = 0; bj < 2; ++bj) *(u32x4*)(d + 32 * bj + 8 * fq) = pack8(acc[ai][bj][m][0], acc[ai][bj][m][1]);
                    }
                }
        } else if (pn == 11 || pn == 12) {
#pragma unroll
            for (int ai = 0; ai < 2; ++ai)
#pragma unroll
                for (int m = 0; m < 4; ++m) { const int row = rbase + ai * 128 + m * 16;
                    head_norm_rope(acc, ai, m, row, fq, qnw, true, 0.125f, qat + (size_t)row * 512 + (4 * (pn - 11) + wc) * 64); }
        } else if (pn < 6) plain_tile<0, true>(acc, inp, 512, pn - 4, rbase, wc, fq);
        else if (pn < 9) plain_tile<1, true>(acc, qhg, 512, pn - 7, rbase, wc, fq);
        else if (pn < 11) plain_tile<2>(acc, ghg, 512, pn - 9, rbase, wc, fq);
        else {
            const int cb = (pn - 13) * 128 + wc * 32 + 8 * fq;
#pragma unroll
            for (int ai = 0; ai < 2; ++ai)
#pragma unroll
                for (int m = 0; m < 4; ++m) { const int row = rbase + ai * 128 + m * 16; f32x4 r0, r1, a0, a1;
#pragma unroll
                    for (int j = 0; j < 4; ++j) { const float eh0 = __expf(-acc[ai][0][m][0][j]), eh1 = __expf(-acc[ai][0][m][1][j]), ea0 = __expf(-acc[ai][1][m][0][j]), ea1 = __expf(-acc[ai][1][m][1][j]);
                        a0[j] = __builtin_amdgcn_rcpf(1.f + ea0); a1[j] = __builtin_amdgcn_rcpf(1.f + ea1);
                        r0[j] = (1.f + ea0) * __builtin_amdgcn_rcpf(1.f + eh0); r1[j] = (1.f + ea1) * __builtin_amdgcn_rcpf(1.f + eh1); }
                    *(u32x4*)(gates + (size_t)row * 2048 + cb) = pack8(r0, r1); *(u32x4*)(gates + (size_t)row * 2048 + 1024 + cb) = pack8(a0, a1); asm volatile("" ::: "memory"); }
        }
    }
    template <int ACT, bool BLK = false>
    __device__ __forceinline__ void plain_tile(f32x4 (&acc)[2][2][4][2], bf16_t* base, int ld, int ct, int rbase, int wc, int fq) const {
#pragma unroll
        for (int ai = 0; ai < 2; ++ai)
#pragma unroll
            for (int m = 0; m < 4; ++m) { const int row = rbase + ai * 128 + m * 16;
#pragma unroll
                for (int bj = 0; bj < 2; ++bj) { f32x4 v0 = acc[ai][bj][m][0], v1 = acc[ai][bj][m][1];
                    if (ACT) {
#pragma unroll
                        for (int j = 0; j < 4; ++j) { const float s0 = sigm(v0[j]), s1 = sigm(v1[j]);
                            if (ACT == 3) { v0[j] = s0; v1[j] = s1; } else { const float sc = ACT == 1 ? 0.08838834764831845f : 1.f; v0[j] = v0[j] * s0 * sc; v1[j] = v1[j] * s1 * sc; } } }
                    *(u32x4*)(base + (BLK ? ((((size_t)(row >> 5) * 4 + (ct * 2 + bj)) * 32 + (row & 31)) * 128 + wc * 32 + 8 * fq) : ((size_t)row * ld + ct * 256 + bj * 128 + wc * 32 + 8 * fq))) = pack8(v0, v1); asm volatile("" ::: "memory"); } }
    }
};

struct EpiBranch {
    static constexpr bool TWICE = false;
    static constexpr bool PERM = true;
    const bf16_t* gates; bf16_t* mixed;
    __device__ __forceinline__ bool zero_after(const Unit&) const { return false; }
    __device__ __forceinline__ void operator()(f32x4 (&acc)[2][2][4][2], const Unit& u, int wr, int wc, int fr, int fq) const {
        const bool second = u.pm >= 64; const int rbase = (u.pm & 63) * 256 + wr * 64 + fr, cbase = (u.pn & 3) * 256 + wc * 32 + 8 * fq;
#pragma unroll
        for (int ai = 0; ai < 2; ++ai)
#pragma unroll
            for (int m = 0; m < 4; ++m) { const int row = rbase + ai * 128 + m * 16;
#pragma unroll
                for (int bj = 0; bj < 2; ++bj) { const int col = cbase + bj * 128;
                    const u32x4 gq = *(const u32x4*)(gates + (size_t)row * 2048 + (second ? 1024 : 0) + col);
                    const f32x4 g0 = {bf_lo(gq.x), bf_hi(gq.x), bf_lo(gq.y), bf_hi(gq.y)}, g1 = {bf_lo(gq.z), bf_hi(gq.z), bf_lo(gq.w), bf_hi(gq.w)};
                    if (!second) { acc[ai][bj][m][0] *= g0; acc[ai][bj][m][1] *= g1; }
                    else { *(u32x4*)(mixed + (size_t)row * 1024 + col) = pack8(acc[ai][bj][m][0] * g0, acc[ai][bj][m][1] * g1); acc[ai][bj][m][0] = (f32x4){0.f, 0.f, 0.f, 0.f}; acc[ai][bj][m][1] = (f32x4){0.f, 0.f, 0.f, 0.f}; }
                } }
    }
};

struct EpiRes {
    static constexpr bool PERM = true;
    const float* xin; const float* g; float* dst;
    __device__ __forceinline__ bool zero_after(const Unit&) const { return true; }
    __device__ __forceinline__ void operator()(f32x4 (&acc)[2][2][4][2], const Unit& u, int wr, int wc, int fr, int fq) const {
        const int rbase = u.pm * 256 + wr * 64 + fr, cbase = u.pn * 256 + wc * 32 + 8 * fq; const float* gb = g + (size_t)(u.pm >> 3) * 6144;
#pragma unroll
        for (int bj = 0; bj < 2; ++bj) { const int col = cbase + bj * 128; const f32x4 g0 = *(const f32x4*)(gb + col), g1 = *(const f32x4*)(gb + col + 4);
#pragma unroll
            for (int ai = 0; ai < 2; ++ai)
#pragma unroll
                for (int m = 0; m < 4; ++m) { const size_t o = (size_t)(rbase + ai * 128 + m * 16) * 1024 + col;
                    const f32x4 x0 = *(const f32x4*)(xin + o), x1 = *(const f32x4*)(xin + o + 4);
                    *(f32x4*)(dst + o) = x0 + g0 * acc[ai][bj][m][0]; *(f32x4*)(dst + o + 4) = x1 + g1 * acc[ai][bj][m][1]; } }
    }
};

struct EpiGU {
    static constexpr bool TWICE = false;
    static constexpr bool PERM = true;
    bf16_t* act;
    __device__ __forceinline__ bool zero_after(const Unit&) const { return true; }
    __device__ __forceinline__ void operator()(f32x4 (&acc)[2][2][4][2], const Unit& u, int wr, int wc, int fr, int fq) const {
        const int rbase = u.pm * 256 + wr * 64 + fr, cbase = u.pn * 128 + wc * 32 + 8 * fq;
#pragma unroll
        for (int ai = 0; ai < 2; ++ai)
#pragma unroll
            for (int m = 0; m < 4; ++m) { f32x4 r0, r1;
#pragma unroll
                for (int j = 0; j < 4; ++j) { const float g0 = acc[ai][0][m][0][j], g1 = acc[ai][0][m][1][j]; r0[j] = g0 * sigm(g0) * acc[ai][1][m][0][j]; r1[j] = g1 * sigm(g1) * acc[ai][1][m][1][j]; }
                *(u32x4*)(act + (size_t)(rbase + ai * 128 + m * 16) * 2816 + cbase) = pack8(r0, r1); }
    }
};

#define WSP(T, off) ((T*)(p.ws + (off)))

__device__ __forceinline__ void mod_item(const Params& p, int item, LAS float* lds) {
    const int t = tid_(), cg = t & 15, kr = t >> 4;
    for (int i = t; i < 9 * 1024; i += 512) { const int r = i >> 10, k = i & 1023; const float v = r < 8 ? p.c[r * 1024 + k] : p.c_ctx[k]; lds[i] = v * sigm(v); }
    __syncthreads();
    f32x4 a0 = {0.f, 0.f, 0.f, 0.f}, a1 = a0, a2 = a0, a3 = a0, a4 = a0, a5 = a0, a6 = a0, a7 = a0, a8 = a0;
    const float* wp = p.w_ada + (size_t)kr * 6144 + item * 64 + cg * 4;
#pragma unroll 8
    for (int it = 0; it < 32; ++it) { const int k = kr + 32 * it; const f32x4 w = __builtin_nontemporal_load((const f32x4*)(wp + (size_t)it * 32 * 6144));
        a0 += w * lds[k]; a1 += w * lds[1024 + k]; a2 += w * lds[2048 + k]; a3 += w * lds[3072 + k]; a4 += w * lds[4096 + k]; a5 += w * lds[5120 + k]; a6 += w * lds[6144 + k]; a7 += w * lds[7168 + k]; a8 += w * lds[8192 + k]; }
    LAS float* red = lds + 9 * 1024;
    *(LAS f32x4*)(red + ((kr * 9 + 0) * 64 + cg * 4)) = a0; *(LAS f32x4*)(red + ((kr * 9 + 1) * 64 + cg * 4)) = a1; *(LAS f32x4*)(red + ((kr * 9 + 2) * 64 + cg * 4)) = a2;
    *(LAS f32x4*)(red + ((kr * 9 + 3) * 64 + cg * 4)) = a3; *(LAS f32x4*)(red + ((kr * 9 + 4) * 64 + cg * 4)) = a4; *(LAS f32x4*)(red + ((kr * 9 + 5) * 64 + cg * 4)) = a5;
    *(LAS f32x4*)(red + ((kr * 9 + 6) * 64 + cg * 4)) = a6; *(LAS f32x4*)(red + ((kr * 9 + 7) * 64 + cg * 4)) = a7; *(LAS f32x4*)(red + ((kr * 9 + 8) * 64 + cg * 4)) = a8;
    __syncthreads();
    for (int idx = t; idx < 576; idx += 512) { const int r = idx >> 6, cc = idx & 63; float s_ = 0.f;
#pragma unroll 8
        for (int q = 0; q < 32; ++q) s_ += red[(q * 9 + r) * 64 + cc];
        WSP(float, OFF_MOD)[r * 6144 + item * 64 + cc] = s_ + p.b_ada[item * 64 + cc]; }
    __syncthreads();
}

__device__ __forceinline__ void tables_item(const Params& p) {
    const int t = tid_(); float* tab = WSP(float, OFF_TAB);
    for (int i = t; i < 1024; i += 512) { const int pos = i >> 4, f = i & 15; const float inv = powf(10000.f, -(float)f / 16.f), ang = (float)pos * inv; tab[i] = cosf(ang); tab[1024 + i] = sinf(ang); }
    for (int i = t; i < 1024; i += 512) { const int dir = i >> 9, ch = i & 511; const float l0 = p.lb_logits[dir * 1024 + ch], l1 = p.lb_logits[dir * 1024 + 512 + ch]; tab[2048 + i] = 1.f / (1.f + expf(l1 - l0)); }
}

__device__ __forceinline__ void conv_item(const Params& p, int it, LAS float* tile) {
    const float* W; const float* W2 = nullptr; int ldw, K, ntl, kind = 0; bf16_t* dst;
    if (it < 336) { W = p.w_in; ldw = 5376; K = 1024; dst = WSP(bf16_t, OFF_WIN); kind = 1; ntl = 84; }
    else if ((it -= 336) < 32) { W = p.w_bh; ldw = 1024; K = 512; dst = WSP(bf16_t, OFF_WB); ntl = 16; }
    else if ((it -= 32) < 32) { W = p.w_ba; ldw = 1024; K = 512; dst = WSP(bf16_t, OFF_WB) + (size_t)1024 * 512; ntl = 16; }
    else if ((it -= 32) < 64) { W = p.w_out; ldw = 1024; K = 1024; dst = WSP(bf16_t, OFF_WOUT); ntl = 16; }
    else if ((it -= 64) < 352) { W = p.w_gate; W2 = p.w_up; ldw = 2816; K = 1024; dst = WSP(bf16_t, OFF_WGU); kind = 2; ntl = 88; }
    else { it -= 352; W = p.w_dn; ldw = 1024; K = 2816; dst = WSP(bf16_t, OFF_WDN); ntl = 16; }
    const int n0 = (it % ntl) * 64, k0 = (it / ntl) * 256, t = tid_();
    { const int nn = t & 63, kq = t >> 6, n = n0 + nn; int col = n; const float* src = W;
      if (kind == 1) col = in_src_col(n);
      else if (kind == 2) { const int pn = n >> 8, pc = n & 255, bj = pc >> 7, wc = (pc >> 5) & 3, fq = (pc >> 3) & 3, nb = (pc >> 2) & 1, j = pc & 3; col = 128 * pn + 32 * wc + 8 * fq + 4 * nb + j; if (bj) src = W2; }
      float v[32];
#pragma unroll
      for (int i = 0; i < 32; ++i) v[i] = __builtin_nontemporal_load(src + (size_t)(k0 + kq * 32 + i) * ldw + col);
#pragma unroll
      for (int i = 0; i < 32; ++i) tile[(kq * 32 + i) * 65 + nn] = v[i]; }
    __syncthreads();
#pragma unroll
    for (int h = 0; h < 4; ++h) { const int k8 = (t & 7) + 8 * h, n2 = t >> 3; const LAS float* s = tile + (k8 * 8) * 65 + n2;
      u32x4 o; o.x = cvt_pk_bf16(s[0], s[65]); o.y = cvt_pk_bf16(s[130], s[195]); o.z = cvt_pk_bf16(s[260], s[325]); o.w = cvt_pk_bf16(s[390], s[455]);
      *(u32x4*)(dst + (size_t)(n0 + n2) * K + k0 + k8 * 8) = o; }
    __syncthreads();
}

__device__ __forceinline__ void conv_win_half(const Params& p, int it2, LAS float* tile) {
    const int it = it2 >> 1, kh = it2 & 1, n0 = (it % 84) * 64, k0 = (it / 84) * 256 + kh * 128, t = tid_();
    bf16_t* dst = WSP(bf16_t, OFF_WIN);
    { const int nn = t & 63, kq = t >> 6, col = in_src_col(n0 + nn);
      float v[16];
#pragma unroll
      for (int i = 0; i < 16; ++i) v[i] = __builtin_nontemporal_load(p.w_in + (size_t)(k0 + kq * 16 + i) * 5376 + col);
#pragma unroll
      for (int i = 0; i < 16; ++i) tile[(kq * 16 + i) * 65 + nn] = v[i]; }
    __syncthreads();
#pragma unroll
    for (int h = 0; h < 2; ++h) { const int k8 = (t & 7) + 8 * h, n2 = t >> 3; const LAS float* s = tile + (k8 * 8) * 65 + n2;
      u32x4 o; o.x = cvt_pk_bf16(s[0], s[65]); o.y = cvt_pk_bf16(s[130], s[195]); o.z = cvt_pk_bf16(s[260], s[325]); o.w = cvt_pk_bf16(s[390], s[455]);
      *(u32x4*)(dst + (size_t)(n0 + n2) * 1024 + k0 + k8 * 8) = o; }
    __syncthreads();
}

__device__ __forceinline__ void norm_phase(const Params& p, const float* xlat, const float* xctx, int nrows, const float* nw, int sh_off, int sc_off, bf16_t* dst) {
    const int tt = tid_(), lane = tt & 63, gw = blockIdx.x * 8 + (tt >> 6), ngw = gridDim.x * 8; const float* mod = WSP(float, OFF_MOD);
    f32x4 c0, c1, c2, c3;
    { const int r = gw; const float* xr = r < MLAT ? xlat + (size_t)r * 1024 : xctx + (size_t)(r - MLAT) * 1024;
      c0 = *(const f32x4*)(xr + 4 * lane); c1 = *(const f32x4*)(xr + 4 * lane + 256); c2 = *(const f32x4*)(xr + 4 * lane + 512); c3 = *(const f32x4*)(xr + 4 * lane + 768); }
    for (int r = gw; r < nrows; r += ngw) {
        const int rn = r + ngw < nrows ? r + ngw : r; const float* xn = rn < MLAT ? xlat + (size_t)rn * 1024 : xctx + (size_t)(rn - MLAT) * 1024;
        const f32x4 n0 = *(const f32x4*)(xn + 4 * lane), n1 = *(const f32x4*)(xn + 4 * lane + 256), n2 = *(const f32x4*)(xn + 4 * lane + 512), n3 = *(const f32x4*)(xn + 4 * lane + 768);
        const float* mr = mod + (size_t)(r < MLAT ? (r >> 11) : 8) * 6144;
        float ss = (c0[0] * c0[0] + c0[1] * c0[1]) + (c0[2] * c0[2] + c0[3] * c0[3]) + (c1[0] * c1[0] + c1[1] * c1[1]) + (c1[2] * c1[2] + c1[3] * c1[3])
                 + (c2[0] * c2[0] + c2[1] * c2[1]) + (c2[2] * c2[2] + c2[3] * c2[3]) + (c3[0] * c3[0] + c3[1] * c3[1]) + (c3[2] * c3[2] + c3[3] * c3[3]);
#pragma unroll
        for (int o = 1; o < 64; o <<= 1) ss += __shfl_xor(ss, o);
        const float rinv = rsqrtf(ss * (1.f / 1024.f) + EPSN);
        f32x4 v[4] = {c0, c1, c2, c3};
#pragma unroll
        for (int i = 0; i < 4; ++i) { const int ch = 4 * lane + 256 * i; const f32x4 w = *(const f32x4*)(nw + ch), sh = *(const f32x4*)(mr + sh_off + ch), sc = *(const f32x4*)(mr + sc_off + ch);
            const f32x4 y = v[i] * rinv * w * (sc + 1.f) + sh; u32x2 o; o.x = cvt_pk_bf16(y[0], y[1]); o.y = cvt_pk_bf16(y[2], y[3]); *(u32x2*)(dst + (size_t)r * 1024 + ch) = o; }
        c0 = n0; c1 = n1; c2 = n2; c3 = n3;
    }
}

__device__ __forceinline__ void hgrn_item_simple(const Params& p, int item, LAS float* lds) {
    const int t = tid_(), dv = t & 127, kq = t >> 7, dir = item & 1, h = (item >> 1) & 3, b = item >> 3;
    const half_t* lf = WSP(half_t, OFF_LF); const bf16_t* inp = WSP(bf16_t, OFF_INP); const bf16_t* qhg = WSP(bf16_t, OFF_QHG);
    bf16_t* od = (bf16_t*)((unsigned char*)p.out + (dir ? OUT_OB : OUT_OF));
    LAS float* fS = lds; LAS float* qS = lds + 2048; LAS float* vS = lds + 4096; LAS float* red = lds + 6144;
    float S[32];
#pragma unroll
    for (int i = 0; i < 32; ++i) S[i] = 0.f;
    for (int g = 0; g < 144; ++g) {
        const bool lat = g >= 16;
#pragma unroll
        for (int i = 0; i < 4; ++i) { const int pp = 4 * kq + i, sp = 16 * g + pp; int row;
            if (!lat) row = MLAT + b * 256 + (dir ? 255 - sp : sp); else { const int lt = sp - 256; row = b * 2048 + (dir ? 2047 - lt : lt); }
            fS[pp * 128 + dv] = __builtin_amdgcn_exp2f((float)lf[(size_t)row * 1024 + dir * 512 + h * 128 + dv]);
            qS[pp * 128 + dv] = lat ? bf2f(qhg[(size_t)row * 512 + h * 128 + dv]) : 0.f;
            vS[pp * 128 + dv] = bf2f(inp[(size_t)row * 512 + h * 128 + dv]); }
        __syncthreads();
        for (int pp = 0; pp < 16; ++pp) { const float v = vS[pp * 128 + dv]; float part = 0.f;
#pragma unroll
            for (int kk = 0; kk < 32; ++kk) { const float f = fS[pp * 128 + kq * 32 + kk]; S[kk] = f * S[kk] + (1.f - f) * v; part += S[kk] * qS[pp * 128 + kq * 32 + kk]; }
            red[(pp * 4 + kq) * 128 + dv] = part; }
        __syncthreads();
        if (lat) {
#pragma unroll
            for (int i = 0; i < 4; ++i) { const int idx = t + 512 * i, pp = idx >> 7, d2 = idx & 127, lt = 16 * g + pp - 256, row = b * 2048 + (dir ? 2047 - lt : lt);
                const float o = (red[(pp * 4 + 0) * 128 + d2] + red[(pp * 4 + 1) * 128 + d2]) + (red[(pp * 4 + 2) * 128 + d2] + red[(pp * 4 + 3) * 128 + d2]);
                od[(size_t)row * 512 + h * 128 + d2] = f2bf(o); }
        }
    }
    __syncthreads();
}

__device__ __forceinline__ void attn_item_simple(const Params& p, int item, LAS unsigned* lds) {
    const int t = tid_(), g = t >> 7, qi = t & 127, qb = item & 15, kvh = (item >> 4) & 1, b = item >> 5, hq = kvh * 4 + g, tq = qb * 128 + qi;
    const bf16_t* kv = WSP(bf16_t, OFF_KV); const bf16_t* qat = WSP(bf16_t, OFF_QAT); bf16_t* yat = WSP(bf16_t, OFF_QAT);
    float q[64], o[64];
    { const u32x4* qp = (const u32x4*)(qat + (size_t)(b * 2048 + tq) * 512 + hq * 64);
#pragma unroll
      for (int i = 0; i < 8; ++i) { const u32x4 w = qp[i]; q[8 * i] = bf_lo(w.x); q[8 * i + 1] = bf_hi(w.x); q[8 * i + 2] = bf_lo(w.y); q[8 * i + 3] = bf_hi(w.y); q[8 * i + 4] = bf_lo(w.z); q[8 * i + 5] = bf_hi(w.z); q[8 * i + 6] = bf_lo(w.w); q[8 * i + 7] = bf_hi(w.w); } }
#pragma unroll
    for (int i = 0; i < 64; ++i) o[i] = 0.f;
    float mx = p.sinks[hq], l = 1.f;
    LAS unsigned* Ks = lds; LAS unsigned* Vs = lds + 2048;
    for (int tile = 0; tile < 10; ++tile) {
        const bool isctx = tile >= 6; const int ks = isctx ? (tile - 6) * 64 : 128 * (qb - 1) + 64 * tile;
        if (!isctx && (ks < 0 || ks >= 2048)) continue;
        { const int key = t >> 3, part = t & 7; const size_t row = isctx ? (size_t)(MLAT + b * 256 + ks + key) : (size_t)(b * 2048 + ks + key);
          *(LAS u32x4*)(Ks + key * 32 + part * 4) = *(const u32x4*)(kv + row * 256 + kvh * 64 + part * 8);
          *(LAS u32x4*)(Vs + key * 32 + part * 4) = *(const u32x4*)(kv + row * 256 + 128 + kvh * 64 + part * 8); }
        __syncthreads();
        for (int key = 0; key < 64; ++key) {
            float s = 0.f;
#pragma unroll
            for (int i = 0; i < 8; ++i) { const u32x4 w = *(const LAS u32x4*)(Ks + key * 32 + i * 4);
                s += q[8 * i] * bf_lo(w.x) + q[8 * i + 1] * bf_hi(w.x) + q[8 * i + 2] * bf_lo(w.y) + q[8 * i + 3] * bf_hi(w.y) + q[8 * i + 4] * bf_lo(w.z) + q[8 * i + 5] * bf_hi(w.z) + q[8 * i + 6] * bf_lo(w.w) + q[8 * i + 7] * bf_hi(w.w); }
            const int dlt = tq - (ks + key); const bool valid = isctx || (dlt <= 128 && dlt >= -128);
            if (valid) {
                const float mn = fmaxf(mx, s), al = __expf(mx - mn), pe = __expf(s - mn); l = l * al + pe; mx = mn;
#pragma unroll
                for (int i = 0; i < 8; ++i) { const u32x4 w = *(const LAS u32x4*)(Vs + key * 32 + i * 4);
                    o[8 * i] = o[8 * i] * al + pe * bf_lo(w.x); o[8 * i + 1] = o[8 * i + 1] * al + pe * bf_hi(w.x); o[8 * i + 2] = o[8 * i + 2] * al + pe * bf_lo(w.y); o[8 * i + 3] = o[8 * i + 3] * al + pe * bf_hi(w.y);
                    o[8 * i + 4] = o[8 * i + 4] * al + pe * bf_lo(w.z); o[8 * i + 5] = o[8 * i + 5] * al + pe * bf_hi(w.z); o[8 * i + 6] = o[8 * i + 6] * al + pe * bf_lo(w.w); o[8 * i + 7] = o[8 * i + 7] * al + pe * bf_hi(w.w); }
            }
        }
        __syncthreads();
    }
    const float il = 1.f / l; u32x4* yp = (u32x4*)(yat + (size_t)(b * 2048 + tq) * 512 + hq * 64);
#pragma unroll
    for (int i = 0; i < 8; ++i) { u32x4 w; w.x = cvt_pk_bf16(o[8 * i] * il, o[8 * i + 1] * il); w.y = cvt_pk_bf16(o[8 * i + 2] * il, o[8 * i + 3] * il); w.z = cvt_pk_bf16(o[8 * i + 4] * il, o[8 * i + 5] * il); w.w = cvt_pk_bf16(o[8 * i + 6] * il, o[8 * i + 7] * il); yp[i] = w; }
}


#define LDS_BARRIER() do { asm volatile("s_waitcnt lgkmcnt(0)" ::: "memory"); __builtin_amdgcn_s_barrier(); asm volatile("" ::: "memory"); } while (0)
__device__ __forceinline__ void hgrn_item(const Params& p, int item, LAS unsigned char* lds) {
    const int t = tid_(), lane0 = t & 63, w = __builtin_amdgcn_readfirstlane(t >> 6);
    const int dir = item & 1, h = (item >> 1) & 3, b = item >> 3;
    const half_t* lf = WSP(const half_t, OFF_LF) + (size_t)(dir * 4 + h) * 4096;
    const bf16_t* inp = WSP(const bf16_t, OFF_INP) + (size_t)h * 4096;
    const bf16_t* qhg = WSP(const bf16_t, OFF_QHG) + (size_t)h * 4096;
    bf16_t* od = (bf16_t*)((unsigned char*)p.out + (dir ? OUT_OB : OUT_OF)) + h * 128;
    constexpr int SETB = 38400, QD = 0, KD = 8704, KUT = 17408, VT = 27648, DEC = 37888, PP = 76800, QS = 79360, RING = 80896, SLOT = 24576, RQ = 8192, RV = 16384;
    const int pw = w & 3, kh = pw & 1, ph = pw >> 1;
#define HG_RB(cs) ((cs) < 8 ? MLAT + b * 256 + (dir ? 7 - (cs) : (cs)) * 32 : b * 2048 + (dir ? 71 - (cs) : (cs) - 8) * 32)
#define HG_POS(pos) (dir ? 31 - (pos) : (pos))
#define HG_DMA(cs_, slot_) do { const int cc_ = (cs_) < 71 ? (cs_) : 71, rb_ = HG_RB(cc_), qb_ = cc_ >= 8 ? rb_ : 0; LAS unsigned char* sl_ = lds + RING + (slot_) * SLOT; \
        const unsigned char* bl_ = (const unsigned char*)lf + (size_t)(rb_ >> 5) * 65536; const unsigned char* bq_ = (const unsigned char*)qhg + (size_t)(qb_ >> 5) * 32768; const unsigned char* bv_ = (const unsigned char*)inp + (size_t)(rb_ >> 5) * 32768; \
        __builtin_amdgcn_global_load_lds((const unsigned*)(bl_ + dof[0]), (LAS unsigned*)(sl_ + pw * 2048), 16, 0, 2); __builtin_amdgcn_global_load_lds((const unsigned*)(bl_ + dof[1]), (LAS unsigned*)(sl_ + pw * 2048 + 1024), 16, 0, 2); \
        __builtin_amdgcn_global_load_lds((const unsigned*)(bq_ + dof[2]), (LAS unsigned*)(sl_ + RQ + pw * 2048), 16, 0, 2); __builtin_amdgcn_global_load_lds((const unsigned*)(bq_ + dof[3]), (LAS unsigned*)(sl_ + RQ + pw * 2048 + 1024), 16, 0, 2); \
        __builtin_amdgcn_global_load_lds((const unsigned*)(bv_ + dof[4]), (LAS unsigned*)(sl_ + RV + pw * 2048), 16, 0, 2); __builtin_amdgcn_global_load_lds((const unsigned*)(bv_ + dof[5]), (LAS unsigned*)(sl_ + RV + pw * 2048 + 1024), 16, 0, 2); } while (0)
    f32x4 S[8][2];
#pragma unroll
    for (int i = 0; i < 8; ++i) { S[i][0] = (f32x4){0.f, 0.f, 0.f, 0.f}; S[i][1] = (f32x4){0.f, 0.f, 0.f, 0.f}; }
    unsigned dof[6];
    { const int lane = lane0, vp = lane & 31, vd = (lane >> 5) + 2 * pw;
#pragma unroll
      for (int j = 0; j < 2; ++j) { const int pr = HG_POS(16 * ph + 8 * j + (lane >> 3));
          dof[j] = (unsigned)(pr * 128 + 64 * kh + 8 * (lane & 7)) * 2u; dof[2 + j] = dof[j]; dof[4 + j] = (unsigned)(HG_POS(vp) * 128 + (vd + 8 * j) * 8) * 2u; }
      if (w >= 4) { HG_DMA(0, 0); HG_DMA(1, 1); HG_DMA(2, 2); } }
    float cl[16]; unsigned qv[8]; u32x4 vv0, vv1;
    { const int lane = lane0, k = 64 * kh + lane, vp = lane & 31, vd = (lane >> 5) + 2 * pw;
        if (w >= 4) {
            if (true) {
                asm volatile("s_waitcnt vmcnt(12)" ::: "memory");
                const LAS unsigned char* sl = lds + RING;
#pragma unroll
                for (int q = 0; q < 16; ++q) cl[q] = (float)*(const LAS half_t*)(sl + pw * 2048 + q * 128 + lane * 2);
#pragma unroll
                for (int q = 0; q < 8; ++q) qv[q] = (unsigned)*(const LAS bf16_t*)(sl + RQ + pw * 2048 + (2 * q) * 128 + lane * 2) | ((unsigned)*(const LAS bf16_t*)(sl + RQ + pw * 2048 + (2 * q + 1) * 128 + lane * 2) << 16);
                vv0 = *(const LAS u32x4*)(sl + RV + pw * 2048 + lane * 16); vv1 = *(const LAS u32x4*)(sl + RV + pw * 2048 + 1024 + lane * 16);
                asm volatile("s_waitcnt lgkmcnt(0)" ::: "memory");
                HG_DMA(3, 0);
#pragma unroll
                for (int q = 1; q < 16; ++q) cl[q] += cl[q - 1];
                *(LAS float*)(lds + QS + (ph * 128 + k) * 4) = cl[15];
            }
        }
      LDS_BARRIER(); }
#pragma unroll 1
    for (int i = 0; i <= 72; ++i) {
        int lane = lane0; asm volatile("" : "+v"(lane));
        const int n = lane & 15, g = lane >> 4, k = 64 * kh + lane, vp = lane & 31, vd = (lane >> 5) + 2 * pw;
        f32x4 o[2][2]; bf16x8 VB0, VB1;
        const int cs = i - 1; const bool lat = cs >= 8;
        LAS unsigned char* const cset = lds + (cs & 1) * SETB;
        LAS unsigned char* const pset = lds + (i & 1) * SETB;
        if (w >= 4) {
            if (i < 72) {
                const float q0 = *(const LAS float*)(lds + QS + k * 4), q1 = *(const LAS float*)(lds + QS + (128 + k) * 4), tot = q0 + q1, offs = ph ? q0 : 0.f;
                const float etot = __builtin_amdgcn_exp2f(tot); float einv_prev = ph ? __builtin_amdgcn_rcpf(__builtin_amdgcn_exp2f(offs)) : 1.f;
                float kuv[16];
#pragma unroll
                for (int q = 0; q < 16; ++q) { const float e = __builtin_amdgcn_exp2f(offs + cl[q]), einv = __builtin_amdgcn_rcpf(e), kk = 1.f - e * einv_prev; const int pos = 16 * ph + q;
                    *(LAS bf16_t*)(pset + QD + pos * 272 + k * 2) = f2bf(((q & 1) ? bf_hi(qv[q >> 1]) : bf_lo(qv[q >> 1])) * e);
                    *(LAS bf16_t*)(pset + KD + pos * 272 + k * 2) = f2bf(kk * einv);
                    kuv[q] = kk * einv * etot; einv_prev = einv; }
                { u32x4 kw; kw.x = cvt_pk_bf16(kuv[0], kuv[1]); kw.y = cvt_pk_bf16(kuv[2], kuv[3]); kw.z = cvt_pk_bf16(kuv[4], kuv[5]); kw.w = cvt_pk_bf16(kuv[6], kuv[7]); *(LAS u32x4*)(pset + KUT + k * 80 + ph * 32) = kw;
                  kw.x = cvt_pk_bf16(kuv[8], kuv[9]); kw.y = cvt_pk_bf16(kuv[10], kuv[11]); kw.z = cvt_pk_bf16(kuv[12], kuv[13]); kw.w = cvt_pk_bf16(kuv[14], kuv[15]); *(LAS u32x4*)(pset + KUT + k * 80 + ph * 32 + 16) = kw; }
                if (ph == 0) *(LAS float*)(pset + DEC + k * 4) = etot;
                { LAS bf16_t* vt = (LAS bf16_t*)(pset + VT + (vd * 8) * 80 + vp * 2);
                  vt[0] = (bf16_t)(vv0.x & 0xffffu); vt[40] = (bf16_t)(vv0.x >> 16); vt[80] = (bf16_t)(vv0.y & 0xffffu); vt[120] = (bf16_t)(vv0.y >> 16);
                  vt[160] = (bf16_t)(vv0.z & 0xffffu); vt[200] = (bf16_t)(vv0.z >> 16); vt[240] = (bf16_t)(vv0.w & 0xffffu); vt[280] = (bf16_t)(vv0.w >> 16);
                  vt += 64 * 40;
                  vt[0] = (bf16_t)(vv1.x & 0xffffu); vt[40] = (bf16_t)(vv1.x >> 16); vt[80] = (bf16_t)(vv1.y & 0xffffu); vt[120] = (bf16_t)(vv1.y >> 16);
                  vt[160] = (bf16_t)(vv1.z & 0xffffu); vt[200] = (bf16_t)(vv1.z >> 16); vt[240] = (bf16_t)(vv1.w & 0xffffu); vt[280] = (bf16_t)(vv1.w >> 16); }
            }
        } else if (i >= 1) {
            VB0 = *(const LAS bf16x8*)(cset + VT + (32 * w + n) * 80 + 16 * g); VB1 = *(const LAS bf16x8*)(cset + VT + (32 * w + 16 + n) * 80 + 16 * g);
#pragma unroll
            for (int a = 0; a < 2; ++a)
#pragma unroll
                for (int c2 = 0; c2 < 2; ++c2) o[a][c2] = (f32x4){0.f, 0.f, 0.f, 0.f};
            if (lat) {
                {
                    const int mb = w >> 1, nb = w & 1;
                    f32x4 sc = {0.f, 0.f, 0.f, 0.f};
                    if (w != 1) {
#pragma unroll
                        for (int s = 0; s < 4; ++s) { const bf16x8 A = *(const LAS bf16x8*)(cset + QD + (16 * mb + n) * 272 + (32 * s + 8 * g) * 2), B = *(const LAS bf16x8*)(cset + KD + (16 * nb + n) * 272 + (32 * s + 8 * g) * 2);
                            sc = __builtin_amdgcn_mfma_f32_16x16x32_bf16(A, B, sc, 0, 0, 0); }
                    }
#pragma unroll
                    for (int j = 0; j < 4; ++j) { const int c = 16 * mb + 4 * g + j, s_ = 16 * nb + n; *(LAS bf16_t*)(lds + PP + c * 80 + s_ * 2) = f2bf((w != 1 && s_ <= c) ? sc[j] : 0.f); }
                }
#pragma unroll
                for (int s = 0; s < 4; ++s) {
                    bf16x8 A[2];
#pragma unroll
                    for (int mbc = 0; mbc < 2; ++mbc) { const u32x2 lo = *(const LAS u32x2*)(cset + QD + (16 * mbc + n) * 272 + (32 * s + 4 * g) * 2), hi = *(const LAS u32x2*)(cset + QD + (16 * mbc + n) * 272 + (32 * s + 16 + 4 * g) * 2);
                        const u32x4 aw = {lo.x, lo.y, hi.x, hi.y}; A[mbc] = __builtin_bit_cast(bf16x8, aw); }
#pragma unroll
                    for (int c2 = 0; c2 < 2; ++c2) { u32x4 bw; bw.x = cvt_pk_bf16(S[2 * s][c2][0], S[2 * s][c2][1]); bw.y = cvt_pk_bf16(S[2 * s][c2][2], S[2 * s][c2][3]); bw.z = cvt_pk_bf16(S[2 * s + 1][c2][0], S[2 * s + 1][c2][1]); bw.w = cvt_pk_bf16(S[2 * s + 1][c2][2], S[2 * s + 1][c2][3]);
                        const bf16x8 B = __builtin_bit_cast(bf16x8, bw);
                        o[0][c2] = __builtin_amdgcn_mfma_f32_16x16x32_bf16(A[0], B, o[0][c2], 0, 0, 0); o[1][c2] = __builtin_amdgcn_mfma_f32_16x16x32_bf16(A[1], B, o[1][c2], 0, 0, 0); }
                }
            }
#pragma unroll
            for (int mb = 0; mb < 8; ++mb) { const f32x4 d = *(const LAS f32x4*)(cset + DEC + (16 * mb + 4 * g) * 4); const bf16x8 A = *(const LAS bf16x8*)(cset + KUT + (16 * mb + n) * 80 + 16 * g);
                S[mb][0] = __builtin_amdgcn_mfma_f32_16x16x32_bf16(A, VB0, S[mb][0] * d, 0, 0, 0); S[mb][1] = __builtin_amdgcn_mfma_f32_16x16x32_bf16(A, VB1, S[mb][1] * d, 0, 0, 0); }
        }
        LDS_BARRIER();
        if (w >= 4) {
            if (i + 1 < 72) {
                asm volatile("s_waitcnt vmcnt(12)" ::: "memory");
                const int rs_ = (i + 1) % 3; const LAS unsigned char* sl = lds + RING + rs_ * SLOT;
#pragma unroll
                for (int q = 0; q < 16; ++q) cl[q] = (float)*(const LAS half_t*)(sl + pw * 2048 + q * 128 + lane * 2);
#pragma unroll
                for (int q = 0; q < 8; ++q) qv[q] = (unsigned)*(const LAS bf16_t*)(sl + RQ + pw * 2048 + (2 * q) * 128 + lane * 2) | ((unsigned)*(const LAS bf16_t*)(sl + RQ + pw * 2048 + (2 * q + 1) * 128 + lane * 2) << 16);
                vv0 = *(const LAS u32x4*)(sl + RV + pw * 2048 + lane * 16); vv1 = *(const LAS u32x4*)(sl + RV + pw * 2048 + 1024 + lane * 16);
                asm volatile("s_waitcnt lgkmcnt(0)" ::: "memory");
                HG_DMA(i + 4, rs_);
#pragma unroll
                for (int q = 1; q < 16; ++q) cl[q] += cl[q - 1];
                *(LAS float*)(lds + QS + (ph * 128 + k) * 4) = cl[15];
            }
        } else if (i >= 1 && lat) {
            const bf16x8 A0 = *(const LAS bf16x8*)(lds + PP + n * 80 + 16 * g), A1 = *(const LAS bf16x8*)(lds + PP + (16 + n) * 80 + 16 * g);
            o[0][0] = __builtin_amdgcn_mfma_f32_16x16x32_bf16(A0, VB0, o[0][0], 0, 0, 0); o[1][0] = __builtin_amdgcn_mfma_f32_16x16x32_bf16(A1, VB0, o[1][0], 0, 0, 0);
            o[0][1] = __builtin_amdgcn_mfma_f32_16x16x32_bf16(A0, VB1, o[0][1], 0, 0, 0); o[1][1] = __builtin_amdgcn_mfma_f32_16x16x32_bf16(A1, VB1, o[1][1], 0, 0, 0);
            const int rb = HG_RB(cs), st = dir ? -512 : 512;
            bf16_t* orow = od + (size_t)(rb + HG_POS(4 * g)) * 512 + 32 * w + n;
#pragma unroll
            for (int mbc = 0; mbc < 2; ++mbc)
#pragma unroll
                for (int j = 0; j < 4; ++j) { bf16_t* q_ = orow + (16 * mbc + j) * st; q_[0] = f2bf(o[mbc][0][j]); q_[16] = f2bf(o[mbc][1][j]); }
        }
        LDS_BARRIER();
    }
    asm volatile("s_waitcnt vmcnt(0)" ::: "memory");
    __syncthreads();
#undef HG_RB
#undef HG_POS
#undef HG_DMA
}

__device__ __forceinline__ void attn_item(const Params& p, int item, LAS unsigned char* lds) {
    const int t = tid_(), lane = t & 63, w = __builtin_amdgcn_readfirstlane(t >> 6), c32 = lane & 31, hh = lane >> 5;
    const int qb = item & 15, kvh = (item >> 4) & 1, b = item >> 5, hq = kvh * 4 + (w >> 1), qh = w & 1, t0 = qb * 128 + 64 * qh;
    const bf16_t* kv = WSP(const bf16_t, OFF_KV); const bf16_t* qat = WSP(const bf16_t, OFF_QAT); bf16_t* yat = WSP(bf16_t, OFF_QAT);
    constexpr int KS = 0, VTO = 55296, VSTR = 784;
    constexpr float LOG2E = 1.4426950408889634f;
    bf16x8 Qf[2][4];
#pragma unroll
    for (int nb = 0; nb < 2; ++nb)
#pragma unroll
        for (int ds = 0; ds < 4; ++ds) Qf[nb][ds] = *(const bf16x8*)(qat + (size_t)(b * 2048 + t0 + 32 * nb + c32) * 512 + hq * 64 + 16 * ds + 8 * hh);
    f32x16 O[2][2];
#pragma unroll
    for (int a = 0; a < 2; ++a)
#pragma unroll
        for (int d = 0; d < 2; ++d)
#pragma unroll
            for (int r = 0; r < 16; ++r) O[a][d][r] = 0.f;
    float mrun[2], lrun[2];
    mrun[0] = mrun[1] = p.sinks[hq] * LOG2E; lrun[0] = lrun[1] = hh == 0 ? 1.f : 0.f;
    for (int stage = 0; stage < 2; ++stage) {
        const int kbase = stage == 0 ? 128 * (qb - 1) : 0, nkeys = stage == 0 ? 384 : 256;
        __syncthreads();
        {
            u32x4 kr[6], vr[6];
#pragma unroll
            for (int i = 0; i < 6; ++i) { const int idx = t + 512 * i; const int part = stage == 0 ? idx / 384 : idx >> 8, key = stage == 0 ? idx - part * 384 : idx & 255, tok = kbase + key;
                if (idx < nkeys * 8 && (stage == 1 || (tok >= 0 && tok < 2048))) { const size_t row = stage == 0 ? (size_t)(b * 2048 + tok) : (size_t)(MLAT + b * 256 + key);
                    kr[i] = *(const u32x4*)(kv + row * 256 + kvh * 64 + part * 8); vr[i] = *(const u32x4*)(kv + row * 256 + 128 + kvh * 64 + part * 8); }
                else { kr[i] = (u32x4){0u, 0u, 0u, 0u}; vr[i] = (u32x4){0u, 0u, 0u, 0u}; } }
#pragma unroll
            for (int i = 0; i < 6; ++i) { const int idx = t + 512 * i; const int part = stage == 0 ? idx / 384 : idx >> 8, key = stage == 0 ? idx - part * 384 : idx & 255;
                if (idx < nkeys * 8) { *(LAS u32x4*)(lds + KS + key * 144 + part * 16) = kr[i]; const u32x4 v = vr[i];
                    LAS bf16_t* vt = (LAS bf16_t*)(lds + VTO + (part * 8) * VSTR + key * 2);
                    vt[0] = (bf16_t)(v.x & 0xffffu); vt[392] = (bf16_t)(v.x >> 16); vt[784] = (bf16_t)(v.y & 0xffffu); vt[1176] = (bf16_t)(v.y >> 16);
                    vt[1568] = (bf16_t)(v.z & 0xffffu); vt[1960] = (bf16_t)(v.z >> 16); vt[2352] = (bf16_t)(v.w & 0xffffu); vt[2744] = (bf16_t)(v.w >> 16); } }
        }
        __syncthreads();
        const int tl0 = stage == 0 ? 2 * qh : 0, tl1 = stage == 0 ? 2 * qh + 10 : 8;
        for (int tl = tl0; tl < tl1; ++tl) {
            const int ks = kbase + 32 * tl;
            if (stage == 0 && (ks < 0 || ks >= 2048)) continue;
            bf16x8 Kf[4]; u32x4 Vf[2][2];
#pragma unroll
            for (int ds = 0; ds < 4; ++ds) Kf[ds] = *(const LAS bf16x8*)(lds + KS + (32 * tl + c32) * 144 + (16 * ds + 8 * hh) * 2);
#pragma unroll
            for (int md = 0; md < 2; ++md)
#pragma unroll
                for (int s = 0; s < 2; ++s) { const LAS unsigned char* vr = lds + VTO + (32 * md + c32) * VSTR + (32 * tl + 16 * s + 4 * hh) * 2;
                    const u32x2 lo = *(const LAS u32x2*)vr, hi = *(const LAS u32x2*)(vr + 16); Vf[md][s] = (u32x4){lo.x, lo.y, hi.x, hi.y}; }
#pragma unroll
            for (int nb = 0; nb < 2; ++nb) {
                if (stage == 0) { const int rel = tl - 2 * qh; if (rel < nb || rel > nb + 8) continue; }
                f32x16 sc;
#pragma unroll
                for (int r = 0; r < 16; ++r) sc[r] = 0.f;
#pragma unroll
                for (int ds = 0; ds < 4; ++ds) sc = __builtin_amdgcn_mfma_f32_32x32x16_bf16(Kf[ds], Qf[nb][ds], sc, 0, 0, 0);
                const int tq = t0 + 32 * nb + c32;
                float mt = -1e30f;
                const bool edge = stage == 0 && (tl - 2 * qh == nb || tl - 2 * qh == nb + 8);
#pragma unroll
                for (int r = 0; r < 16; ++r) { float v = sc[r] * LOG2E;
                    if (edge) { const int dlt = tq - (ks + 8 * (r >> 2) + 4 * hh + (r & 3)); v = (dlt <= 128 && dlt >= -128) ? v : -1e30f; }
                    sc[r] = v; mt = fmaxf(mt, v); }
                mt = fmaxf(mt, __shfl_xor(mt, 32));
                const float mn = fmaxf(mrun[nb], mt), al = __builtin_amdgcn_exp2f(mrun[nb] - mn); mrun[nb] = mn;
                float ls = 0.f;
#pragma unroll
                for (int r = 0; r < 16; ++r) { const float pe = __builtin_amdgcn_exp2f(sc[r] - mn); sc[r] = pe; ls += pe; }
                lrun[nb] = lrun[nb] * al + ls;
                if (__builtin_amdgcn_ballot_w64(al != 1.f) != 0ull) {
#pragma unroll
                for (int md = 0; md < 2; ++md)
#pragma unroll
                    for (int r = 0; r < 16; ++r) O[nb][md][r] *= al;
                }
#pragma unroll
                for (int s = 0; s < 2; ++s) { u32x4 pw; pw.x = cvt_pk_bf16(sc[8 * s], sc[8 * s + 1]); pw.y = cvt_pk_bf16(sc[8 * s + 2], sc[8 * s + 3]); pw.z = cvt_pk_bf16(sc[8 * s + 4], sc[8 * s + 5]); pw.w = cvt_pk_bf16(sc[8 * s + 6], sc[8 * s + 7]);
                    const bf16x8 Pb = __builtin_bit_cast(bf16x8, pw);
#pragma unroll
                    for (int md = 0; md < 2; ++md) O[nb][md] = __builtin_amdgcn_mfma_f32_32x32x16_bf16(__builtin_bit_cast(bf16x8, Vf[md][s]), Pb, O[nb][md], 0, 0, 0); }
            }
        }
    }
#pragma unroll
    for (int nb = 0; nb < 2; ++nb) { const float lt = lrun[nb] + __shfl_xor(lrun[nb], 32), il = 1.f / lt; bf16_t* yr = yat + (size_t)(b * 2048 + t0 + 32 * nb + c32) * 512 + hq * 64;
#pragma unroll
        for (int md = 0; md < 2; ++md)
#pragma unroll
            for (int i = 0; i < 4; ++i) { u32x2 o; o.x = cvt_pk_bf16(O[nb][md][4 * i] * il, O[nb][md][4 * i + 1] * il); o.y = cvt_pk_bf16(O[nb][md][4 * i + 2] * il, O[nb][md][4 * i + 3] * il);
                *(u32x2*)(yr + 32 * md + 8 * i + 4 * hh) = o; } }
}

__device__ __forceinline__ void readout_phase(const Params& p) {
    const int tt = tid_(), lane = tt & 63, gw = blockIdx.x * 8 + (tt >> 6), ngw = gridDim.x * 8;
    const bf16_t* of = (const bf16_t*)((unsigned char*)p.out + OUT_OF); const bf16_t* ob = (const bf16_t*)((unsigned char*)p.out + OUT_OB); bf16_t* yh = WSP(bf16_t, OFF_GHG);
    const bf16_t* ghg = WSP(bf16_t, OFF_GHG);
    const f32x4 w0 = *(const f32x4*)(p.hgrn_norm_w + (lane & 15) * 8), w1 = *(const f32x4*)(p.hgrn_norm_w + (lane & 15) * 8 + 4);
    for (int r0 = gw; r0 < MLAT; r0 += 4 * ngw) {
        u32x4 a[4], bq[4], gg[4];
#pragma unroll
        for (int j = 0; j < 4; ++j) { const size_t o = (size_t)(r0 + j * ngw) * 512 + lane * 8; a[j] = __builtin_nontemporal_load((const u32x4*)(of + o)); bq[j] = __builtin_nontemporal_load((const u32x4*)(ob + o)); gg[j] = __builtin_nontemporal_load((const u32x4*)(ghg + o)); }
#pragma unroll
        for (int j = 0; j < 4; ++j) { const size_t o = (size_t)(r0 + j * ngw) * 512 + lane * 8;
            f32x4 s0 = {bf_lo(a[j].x) + bf_lo(bq[j].x), bf_hi(a[j].x) + bf_hi(bq[j].x), bf_lo(a[j].y) + bf_lo(bq[j].y), bf_hi(a[j].y) + bf_hi(bq[j].y)};
            f32x4 s1 = {bf_lo(a[j].z) + bf_lo(bq[j].z), bf_hi(a[j].z) + bf_hi(bq[j].z), bf_lo(a[j].w) + bf_lo(bq[j].w), bf_hi(a[j].w) + bf_hi(bq[j].w)};
            float ss = (s0[0] * s0[0] + s0[1] * s0[1]) + (s0[2] * s0[2] + s0[3] * s0[3]) + (s1[0] * s1[0] + s1[1] * s1[1]) + (s1[2] * s1[2] + s1[3] * s1[3]);
            ss += __shfl_xor(ss, 1); ss += __shfl_xor(ss, 2); ss += __shfl_xor(ss, 4); ss += __shfl_xor(ss, 8);
            const float rinv = rsqrtf(ss * (1.f / 128.f) + EPSN);
            const f32x4 g0 = {bf_lo(gg[j].x), bf_hi(gg[j].x), bf_lo(gg[j].y), bf_hi(gg[j].y)}, g1 = {bf_lo(gg[j].z), bf_hi(gg[j].z), bf_lo(gg[j].w), bf_hi(gg[j].w)};
            *(u32x4*)(yh + o) = pack8(s0 * rinv * w0 * g0, s1 * rinv * w1 * g1); }
    }
}

#define XB_TMO      128
#define XB_XCNT(j)  (256  + 64 * (j))
#define XB_XSUB(j)  (1280 + 64 * (j))
#define XB_XGEN(j)  (2304 + 64 * (j))
#define XB_TOP      3328
#define XB_TOPGEN   3392
#define XCD_BAR_WORDS 3456
#define XB_SPIN_CAP (1u << 18)
__device__ __forceinline__ unsigned xb_ld(unsigned* p)              { return __hip_atomic_load(p, __ATOMIC_RELAXED, __HIP_MEMORY_SCOPE_AGENT); }
__device__ __forceinline__ unsigned xb_add(unsigned* p, unsigned v) { return __hip_atomic_fetch_add(p, v, __ATOMIC_RELAXED, __HIP_MEMORY_SCOPE_AGENT); }
__device__ __forceinline__ unsigned xb_xcc_id() { return (unsigned)__builtin_amdgcn_s_getreg((3 << 11) | 20) & 0xFu; }
#define XB_SPIN(cond, bar) do { unsigned _sp = 0; while (cond) { __builtin_amdgcn_s_sleep(1); \
    if ((++_sp & 255u) == 0u) { if (xb_ld(&(bar)[XB_TMO])) break; if (_sp > XB_SPIN_CAP) { atomicAdd(&(bar)[XB_TMO], 1u); break; } } } } while (0)
struct XcdBarrier { unsigned* bar; unsigned x; volatile LAS unsigned* st; };
__device__ __forceinline__ XcdBarrier xcd_barrier_post(unsigned* bar, volatile LAS unsigned* st) {
    XcdBarrier b; b.bar = bar; b.x = xb_xcc_id(); b.st = st;
    if (threadIdx.x == 0) (void)xb_add(&bar[XB_XCNT(b.x)], 1u);
    return b;
}
__device__ __forceinline__ void xcd_barrier_complete(unsigned* bar, unsigned x, unsigned& nloc, unsigned& nx) {
    const unsigned G = gridDim.x * gridDim.y * gridDim.z;
    unsigned sum, cnt, mine, sp = 0u;
    for (;;) {
        sum = 0u; cnt = 0u; mine = 0u;
#pragma unroll
        for (unsigned j = 0; j < 16; ++j) { const unsigned c = xb_ld(&bar[XB_XCNT(j)]); sum += c; cnt += (c > 0u) ? 1u : 0u; mine = (j == x) ? c : mine; }
        if (sum == G) break;
        __builtin_amdgcn_s_sleep(1);
        if ((++sp & 255u) == 0u) { if (xb_ld(&bar[XB_TMO])) break; if (sp > XB_SPIN_CAP) { atomicAdd(&bar[XB_TMO], 1u); break; } }
    }
    nloc = mine > 0u ? mine : 1u; nx = cnt > 0u ? cnt : 1u;
}
__device__ __forceinline__ void xcd_barrier(const XcdBarrier& b) {
    asm volatile("s_waitcnt vmcnt(0)" ::: "memory");
    __syncthreads();
    if (threadIdx.x == 0) {
        unsigned* bar = b.bar;
        __builtin_amdgcn_s_waitcnt(0);
        unsigned nloc = b.st[0], nx = b.st[1];
        if (nloc == 0u) { xcd_barrier_complete(bar, b.x, nloc, nx); b.st[0] = nloc; b.st[1] = nx; }
        const unsigned old = xb_add(&bar[XB_XSUB(b.x)], 1u);
        const unsigned gen = old / nloc;
        if (old + 1u == (gen + 1u) * nloc) {
            __builtin_amdgcn_fence(__ATOMIC_RELEASE, "agent");
            asm volatile("s_waitcnt vmcnt(0)" ::: "memory");
            const unsigned og = xb_add(&bar[XB_TOP], 1u);
            const unsigned tg = og / nx;
            if (og + 1u == (tg + 1u) * nx) xb_add(&bar[XB_TOPGEN], 1u);
            else XB_SPIN(xb_ld(&bar[XB_TOPGEN]) == tg, bar);
            __builtin_amdgcn_fence(__ATOMIC_ACQUIRE, "agent");
            xb_add(&bar[XB_XGEN(b.x)], 1u);
            asm volatile("s_waitcnt vmcnt(0)" ::: "memory");
        } else {
            XB_SPIN(xb_ld(&bar[XB_XGEN(b.x)]) == gen, bar);
            __builtin_amdgcn_fence(__ATOMIC_ACQUIRE, "agent");
            asm volatile("s_waitcnt vmcnt(0)" ::: "memory");
        }
    }
    __syncthreads();
}

constexpr int N_PHASES = 10;
#ifndef PH_MASK
#define PH_MASK 0x3ff
#endif
#define PH_ON(n) ((PH_MASK >> (n)) & 1)
__global__ void __launch_bounds__(512, 2) mega(Params p, int ph_lo, int ph_hi) {
    extern __shared__ __attribute__((aligned(16))) unsigned char shm[];
    LAS unsigned char* lds = (LAS unsigned char*)shm;
    const int G0 = gridDim.x, c0 = blockIdx.x;
    volatile LAS unsigned* xst = (volatile LAS unsigned*)(lds + LDS_WORK);
    if (threadIdx.x == 0) { xst[0] = 0u; xst[1] = 0u; }
    __syncthreads();
    const XcdBarrier xb = xcd_barrier_post((unsigned*)(p.ws + OFF_BAR), xst);
    if (ph_hi > 1000) cg::this_grid().sync();
    for (int ph = ph_lo; ph < ph_hi; ++ph) {
        int G = G0, c = c0; asm volatile("" : "+s"(G), "+s"(c));
        if (ph > ph_lo) xcd_barrier(xb);
        for (int rep = 0; rep < (((PROBE_MASK >> ph) & 1) ? PROBE_N : 1); ++rep) {
        if (rep) xcd_barrier(xb);
        switch (ph) {
#if PH_ON(0)
        case 0: {
            if (c < 96) mod_item(p, c, (LAS float*)lds);
            else { if (c == 96) tables_item(p);
                   for (int it2 = c - 96; it2 < 672; it2 += G - 96) conv_win_half(p, it2, (LAS float*)lds); }
        } break;
#endif
#if PH_ON(1)
        case 1: norm_phase(p, p.x, p.ctx, MALL, p.norm_mix_w, 0, 1024, (bf16_t*)p.out); break;
#endif
#if PH_ON(2)
        case 2: {
            pg8::Gemm g{(const bf16_t*)p.out, WSP(const bf16_t, OFF_WIN), 1024}; SchedInA S{G, c};
            const float* tab = WSP(const float, OFF_TAB);
            EpiIn E{WSP(half_t, OFF_LF), WSP(bf16_t, OFF_INP), WSP(bf16_t, OFF_KV), WSP(bf16_t, OFF_QHG), WSP(bf16_t, OFF_GHG), WSP(bf16_t, OFF_QAT), WSP(bf16_t, OFF_GATES), tab + 2048, tab, tab + 1024, p.q_norm_w, p.k_norm_w};
            pg8::gemm_phase<EpiIn, SchedInA, true, true>(lds, g, S, E);
        } break;
#endif
#if PH_ON(3)
        case 3: {
            if (c < 64) { hgrn_item(p, c, lds); for (int it = 336 + c; it < 336 + 0; it += 64) conv_item(p, it, (LAS float*)lds); }
            else {
                const int cc = c - 64, GB = G - 64;
                { pg8::Gemm g{(const bf16_t*)p.out, WSP(const bf16_t, OFF_WIN), 1024}; SchedInB S{GB, cc};
                  const float* tab = WSP(const float, OFF_TAB);
                  EpiIn E{WSP(half_t, OFF_LF), WSP(bf16_t, OFF_INP), WSP(bf16_t, OFF_KV), WSP(bf16_t, OFF_QHG), WSP(bf16_t, OFF_GHG), WSP(bf16_t, OFF_QAT), WSP(bf16_t, OFF_GATES), tab + 2048, tab, tab + 1024, p.q_norm_w, p.k_norm_w};
                  pg8::gemm_phase<EpiIn, SchedInB, true, true>(lds, g, S, E); }
                for (int it = (cc + GB - 56) % GB; it < 256; it += GB) attn_item(p, it, lds);
                __syncthreads();
                for (int it = 336 + 0 + (cc + GB - 120) % GB; it < 992; it += GB) conv_item(p, it, (LAS float*)lds);
            }
        } break;
#endif
#if PH_ON(4)
        case 4: readout_phase(p); break;
#endif
#if PH_ON(5)
        case 5: {
            pg8::Gemm g{WSP(const bf16_t, OFF_GHG), WSP(const bf16_t, OFF_WB), 512}; SchedPair S{G, c};
            EpiBranch E{WSP(const bf16_t, OFF_GATES), WSP(bf16_t, OFF_MIXED)};
            pg8::gemm_phase<EpiBranch, SchedPair, true, true>(lds, g, S, E);
        } break;
#endif
#if PH_ON(6)
        case 6: {
            pg8::Gemm g{WSP(const bf16_t, OFF_MIXED), WSP(const bf16_t, OFF_WOUT), 1024}; SchedPlain S{64, 4, G, c};
            EpiRes E{p.x, WSP(const float, OFF_MOD) + 2048, p.out};
            pg8::gemm_phase<EpiRes, SchedPlain, false, true>(lds, g, S, E);
        } break;
#endif
#if PH_ON(7)
        case 7: norm_phase(p, p.out, nullptr, MLAT, p.norm_ffn_w, 3072, 4096, WSP(bf16_t, OFF_H2)); break;
#endif
#if PH_ON(8)
        case 8: {
            pg8::Gemm g{WSP(const bf16_t, OFF_H2), WSP(const bf16_t, OFF_WGU), 1024}; SchedPlain S{64, 22, G, c};
            EpiGU E{WSP(bf16_t, OFF_ACT)};
            pg8::gemm_phase<EpiGU, SchedPlain, true, true>(lds, g, S, E);
        } break;
#endif
#if PH_ON(9)
        case 9: {
            pg8::Gemm g{WSP(const bf16_t, OFF_ACT), WSP(const bf16_t, OFF_WDN), 2816}; SchedPlain S{64, 4, G, c};
            EpiRes E{p.out, WSP(const float, OFF_MOD) + 5120, p.out};
            pg8::gemm_phase<EpiRes, SchedPlain, false, true>(lds, g, S, E);
        } break;
#endif
        }
        }
    }
}

extern "C" void kernel_launch(void* const* d_in, const int* in_sizes, int n_in, void* d_out, int out_size, void* d_ws, size_t ws_size, hipStream_t stream) {
    static int grid = 0;
    if (grid == 0) {
        if (n_in != 20 || ws_size < WS_END) { fprintf(stderr, "kernel_launch: unexpected n_in %d / ws_size %zu (need %zu)\n", n_in, ws_size, (size_t)WS_END); grid = -1; return; }
        int dev = 0, cus = 0, per_cu = 0;
        hipGetDevice(&dev); hipDeviceGetAttribute(&cus, hipDeviceAttributeMultiprocessorCount, dev);
        if (hipFuncSetAttribute((const void*)mega, hipFuncAttributeMaxDynamicSharedMemorySize, LDS_BYTES) != hipSuccess) { fprintf(stderr, "kernel_launch: hipFuncSetAttribute failed\n"); grid = -1; return; }
        if (hipOccupancyMaxActiveBlocksPerMultiprocessor(&per_cu, (const void*)mega, 512, LDS_BYTES) != hipSuccess || per_cu < 1) { fprintf(stderr, "kernel_launch: occupancy query gave %d\n", per_cu); per_cu = 1; }
        (void)hipGetLastError();
        grid = cus * 1;
    }
    if (grid < 0) return;
    Params p{};
    const float** pp = (const float**)&p;
    for (int i = 0; i < 20; ++i) pp[i] = (const float*)d_in[i];
    p.out = (float*)d_out; p.ws = (unsigned char*)d_ws;
#if COOP
    if (hipMemsetAsync((unsigned char*)d_ws + OFF_BAR, 0, BAR_BYTES, stream) != hipSuccess) { fprintf(stderr, "kernel_launch: memset of the barrier words failed\n"); return; }
    int lo = 0, hi = N_PHASES; void* args[] = {&p, &lo, &hi};
    hipError_t e = hipLaunchCooperativeKernel((const void*)mega, dim3(grid), dim3(512), args, LDS_BYTES, stream);
    if (e != hipSuccess) fprintf(stderr, "cooperative launch failed: %s (grid %d)\n", hipGetErrorString(e), grid);
#else
    for (int ph = 0; ph < N_PHASES; ++ph) hipLaunchKernelGGL(mega, dim3(grid), dim3(512), LDS_BYTES, stream, p, ph, ph + 1);
#endif
}
```

```cpp
#include <hip/hip_runtime.h>
#include <hip/hip_cooperative_groups.h>
#include <cstdio>
#include <cstdint>
namespace cg = cooperative_groups;

#ifndef COOP
#define COOP 1
#endif
#ifndef PROBE_MASK
#define PROBE_MASK 0
#define PROBE_N 1
#endif
#ifndef HGRN_FAST
#define HGRN_FAST 1
#endif
#ifndef ATTN_FAST
#define ATTN_FAST 1
#endif

#define LAS __attribute__((address_space(3)))
typedef unsigned short bf16_t;
typedef short bf16x8 __attribute__((ext_vector_type(8)));
typedef float f32x4 __attribute__((ext_vector_type(4)));
typedef unsigned u32x4 __attribute__((ext_vector_type(4)));
typedef unsigned u32x2 __attribute__((ext_vector_type(2)));

constexpr int MLAT = 16384, MALL = 18432;
constexpr float EPSN = 1e-6f;
constexpr int LDS_WORK = 154624, LDS_BYTES = LDS_WORK + 16;

constexpr size_t OFF_WIN = 0;
constexpr size_t OFF_WB = OFF_WIN + (size_t)5376 * 1024 * 2;
constexpr size_t OFF_WOUT = OFF_WB + (size_t)2048 * 512 * 2;
constexpr size_t OFF_WGU = OFF_WOUT + (size_t)1024 * 1024 * 2;
constexpr size_t OFF_WDN = OFF_WGU + (size_t)5632 * 1024 * 2;
constexpr size_t OFF_MOD = OFF_WDN + (size_t)1024 * 2816 * 2;
constexpr size_t OFF_TAB = OFF_MOD + (size_t)9 * 6144 * 4;
constexpr size_t OFF_LF = OFF_TAB + 12288;
constexpr size_t OFF_INP = OFF_LF + (size_t)MALL * 1024 * 4;
constexpr size_t OFF_KV = OFF_INP + (size_t)MALL * 512 * 2;
constexpr size_t OFF_QHG = OFF_KV + (size_t)MALL * 256 * 2;
constexpr size_t OFF_GHG = OFF_QHG + (size_t)MLAT * 512 * 2;
constexpr size_t OFF_QAT = OFF_GHG + (size_t)MLAT * 512 * 2;
constexpr size_t OFF_GATES = OFF_QAT + (size_t)MLAT * 512 * 2;
constexpr size_t OFF_BAR = OFF_GATES + (size_t)MLAT * 2048 * 2;
constexpr size_t BAR_BYTES = 3456 * 4;
constexpr size_t WS_END = OFF_BAR + BAR_BYTES;
constexpr size_t OFF_MIXED = OFF_LF;
constexpr size_t OFF_H2 = OFF_LF + (size_t)MLAT * 1024 * 2;
constexpr size_t OFF_ACT = OFF_INP;
constexpr size_t OUT_OF = (size_t)MLAT * 1024 * 2, OUT_OB = OUT_OF + (size_t)MLAT * 512 * 2;

struct Params {
    const float *x, *c, *ctx, *c_ctx, *w_ada, *b_ada, *norm_mix_w, *norm_ffn_w, *w_in, *lb_logits, *hgrn_norm_w, *q_norm_w, *k_norm_w, *sinks, *w_bh, *w_ba, *w_out, *w_gate, *w_up, *w_dn;
    float* out; unsigned char* ws;
};

__device__ __forceinline__ int tid_() { int t = threadIdx.x; asm volatile("" : "+v"(t)); return t; }
typedef float f32x2_t __attribute__((ext_vector_type(2)));
typedef __bf16 bf16x2_t __attribute__((ext_vector_type(2)));
typedef float f32x16 __attribute__((ext_vector_type(16)));
typedef _Float16 half_t;
typedef _Float16 half2_t __attribute__((ext_vector_type(2)));
__device__ __forceinline__ unsigned cvt_pk_f16(float lo, float hi) { const f32x2_t v = {lo, hi}; return __builtin_bit_cast(unsigned, __builtin_convertvector(v, half2_t)); }
__device__ __forceinline__ unsigned cvt_pk_bf16(float lo, float hi) { const f32x2_t v = {lo, hi}; return __builtin_bit_cast(unsigned, __builtin_convertvector(v, bf16x2_t)); }
__device__ __forceinline__ float bf_lo(unsigned u) { return __uint_as_float(u << 16); }
__device__ __forceinline__ float bf_hi(unsigned u) { return __uint_as_float(u & 0xffff0000u); }
__device__ __forceinline__ float bf2f(bf16_t b) { return __uint_as_float(((unsigned)b) << 16); }
__device__ __forceinline__ bf16_t f2bf(float f) { return (bf16_t)(cvt_pk_bf16(f, 0.f) & 0xffffu); }
__device__ __forceinline__ float sigm(float z) { return __builtin_amdgcn_rcpf(1.f + __expf(-z)); }
__device__ __forceinline__ u32x4 pack8(const f32x4 a, const f32x4 b) { u32x4 w; w.x = cvt_pk_bf16(a[0], a[1]); w.y = cvt_pk_bf16(a[2], a[3]); w.z = cvt_pk_bf16(b[0], b[1]); w.w = cvt_pk_bf16(b[2], b[3]); return w; }

namespace pg8 {
constexpr int BM = 256, BK = 64, HALF = 128, HTB = HALF * BK * 2, STAGE_BYTES = 8 * HTB, NXCD = 8, WGM = 8;
__host__ __device__ __forceinline__ int lds_byte(int r, int c) { const int st = (r >> 4) * 2 + (c >> 5), rr = r & 15, cc = c & 31, ob = rr * 64 + cc * 2; return st * 1024 + (ob ^ (((ob >> 9) & 1) << 5)); }
__host__ __device__ __forceinline__ void stage_rc(int b, int& R, int& C) { const int st = b / 1024, sb = b % 1024, swz = sb ^ (((sb >> 9) & 1) << 5); R = (st >> 1) * 16 + swz / 64; C = (st & 1) * 32 + (swz % 64) / 2; }
__host__ __device__ __forceinline__ int perm32(int rho) { const int n = rho >> 4, i = rho & 15; return 8 * (i >> 2) + 4 * n + (i & 3); }
struct Unit { int pm, pn; };
struct Gemm { const bf16_t* A; const bf16_t* Bt; int K; };

__device__ __forceinline__ void static_map(int L, int nM, int nN, Unit& u) {
    const int nwg = nM * nN; int wgid = L;
    { const int q = nwg / NXCD, r = nwg % NXCD, xcd = wgid % NXCD, off = wgid / NXCD; wgid = (xcd < r ? xcd * (q + 1) : r * (q + 1) + (xcd - r) * q) + off; }
    const int nig = WGM * nN, gid = wgid / nig, fm = gid * WGM, gsz = (nM - fm) < WGM ? (nM - fm) : WGM;
    u.pm = fm + ((wgid % nig) % gsz); u.pn = (wgid % nig) / gsz;
}

template <class Epi, class Sched, bool ALIGN_EPI, bool SP2>
__device__ __forceinline__ void gemm_phase(LAS unsigned char* lds, const Gemm g, const Sched& S, const Epi& E) {
    const int tid = tid_(), wid = __builtin_amdgcn_readfirstlane(tid >> 6), lane = tid & 63, wr = wid >> 2, wc = wid & 3, fr = lane & 15, fq = lane >> 4;
    int K_ = g.K; asm volatile("" : "+s"(K_)); const int K = K_, nt = K / BK;
    unsigned voffA[2], voffB[2];
#pragma unroll
    for (int i = 0; i < 2; ++i) { int R, C; stage_rc(tid * 16 + i * 8192, R, C); const int Rb = Epi::PERM ? ((R & ~31) + perm32(R & 31)) : R;
        voffA[i] = (unsigned)(R * K + C) * 2u; voffB[i] = (unsigned)(Rb * K + C) * 2u; }
    const size_t kstep = (size_t)(BK * 2);
    const size_t hstep = (size_t)HALF * K * 2;
    const size_t tstep = 2 * hstep;
    const unsigned ldsw = (unsigned)wid * 1024u;
    const int aoff = lds_byte(wr * 64 + fr, fq * 8), boff = lds_byte(wc * 32 + fr, fq * 8);
#define PG8_SA(b, h) (((b) * 2 + (h)) * HTB)
#define PG8_SB(b, h) ((4 + (b) * 2 + (h)) * HTB)
#define PG8_STAGE(bufoff, gbase, voff) do { _Pragma("unroll") for (int _i = 0; _i < 2; ++_i) \
        __builtin_amdgcn_global_load_lds((const unsigned*)((const char*)(gbase) + (voff)[_i]), (LAS unsigned*)(lds + (bufoff) + ldsw + _i * 8192), 16, 0, 0); } while (0)
#define PG8_LDA(dst, b, h) do { _Pragma("unroll") for (int m = 0; m < 4; ++m) _Pragma("unroll") for (int k = 0; k < 2; ++k) dst[m][k] = *(const LAS bf16x8*)(lds + PG8_SA(b, h) + aoff + m * 2048 + k * 1024); } while (0)
#define PG8_LDB(dst, b, h) do { _Pragma("unroll") for (int n = 0; n < 2; ++n) _Pragma("unroll") for (int k = 0; k < 2; ++k) dst[n][k] = *(const LAS bf16x8*)(lds + PG8_SB(b, h) + boff + n * 2048 + k * 1024); } while (0)
#define PG8_MMA(ai, bj, At, Bt) do { __builtin_amdgcn_s_setprio(1); _Pragma("unroll") for (int m = 0; m < 4; ++m) _Pragma("unroll") for (int n = 0; n < 2; ++n) _Pragma("unroll") for (int k = 0; k < 2; ++k) \
        acc[ai][bj][m][n] = __builtin_amdgcn_mfma_f32_16x16x32_bf16(Bt[n][k], At[m][k], acc[ai][bj][m][n], 0, 0, 0); __builtin_amdgcn_s_setprio(0); } while (0)
#define PG8_WAIT_V(n) asm volatile("s_waitcnt vmcnt(" #n ")" ::: "memory")
#define PG8_WAIT_L(n) asm volatile("s_waitcnt lgkmcnt(" #n ")" ::: "memory")
#define PG8_BAR __builtin_amdgcn_s_barrier()
#define PG8_SCHED __builtin_amdgcn_sched_barrier(0)
    Unit cur, nxt; int ui = 0;
    if (!S.next(0, cur)) return;
    f32x4 acc[2][2][4][2];
#pragma unroll
    for (int a = 0; a < 2; ++a)
#pragma unroll
        for (int b = 0; b < 2; ++b)
#pragma unroll
            for (int m = 0; m < 4; ++m)
#pragma unroll
                for (int n = 0; n < 2; ++n) acc[a][b][m][n] = (f32x4){0.f, 0.f, 0.f, 0.f};
    bf16x8 At[4][2], B0[2][2], B1[2][2];
    const char* cA = (const char*)g.A + (size_t)cur.pm * tstep; const char* cB = (const char*)g.Bt + (size_t)cur.pn * tstep;
    if constexpr (SP2) {
        PG8_STAGE(PG8_SB(0, 0), cB, voffB); PG8_STAGE(PG8_SB(0, 1), cB + hstep, voffB); PG8_STAGE(PG8_SA(0, 0), cA, voffA); PG8_STAGE(PG8_SA(0, 1), cA + hstep, voffA);
        if (wr == 1) PG8_BAR;
        PG8_WAIT_V(2); PG8_BAR;
        PG8_STAGE(PG8_SB(1, 0), cB + kstep, voffB); PG8_STAGE(PG8_SA(1, 0), cA + kstep, voffA); PG8_STAGE(PG8_SB(1, 1), cB + hstep + kstep, voffB);
        PG8_WAIT_V(6); PG8_BAR;
    } else {
        PG8_STAGE(PG8_SB(0, 0), cB, voffB); PG8_STAGE(PG8_SA(0, 0), cA, voffA); PG8_STAGE(PG8_SB(0, 1), cB + hstep, voffB); PG8_STAGE(PG8_SA(0, 1), cA + hstep, voffA);
        if (wr == 1) PG8_BAR;
        PG8_WAIT_V(4); PG8_BAR;
        PG8_STAGE(PG8_SB(1, 0), cB + kstep, voffB); PG8_STAGE(PG8_SA(1, 0), cA + kstep, voffA); PG8_STAGE(PG8_SB(1, 1), cB + hstep + kstep, voffB);
        PG8_WAIT_V(6); PG8_BAR;
    }
    for (;;) {
        const bool has_next = S.next(ui + 1, nxt);
        const char* nA = has_next ? (const char*)g.A + (size_t)nxt.pm * tstep : cA; const char* nB = has_next ? (const char*)g.Bt + (size_t)nxt.pn * tstep : cB;
#pragma unroll 1
        for (int t = 0; t < nt; t += 2) {
            const bool last = (t == nt - 2);
            const char* a1 = cA + (size_t)(t + 1) * kstep;
            const char* a2 = last ? nA : cA + (size_t)(t + 2) * kstep; const char* b2 = last ? nB : cB + (size_t)(t + 2) * kstep;
            const char* a3 = a2 + kstep; const char* b3 = b2 + kstep;
            if constexpr (SP2) {
            PG8_LDB(B0, 0, 0); PG8_LDB(B1, 0, 1); PG8_SCHED; PG8_LDA(At, 0, 0); PG8_STAGE(PG8_SA(1, 1), a1 + hstep, voffA);
            PG8_WAIT_V(8); PG8_WAIT_L(0); PG8_BAR; PG8_MMA(0, 0, At, B0); PG8_MMA(0, 1, At, B1); PG8_BAR; PG8_SCHED;
            PG8_LDA(At, 0, 1); PG8_STAGE(PG8_SB(0, 0), b2, voffB); PG8_STAGE(PG8_SB(0, 1), b2 + hstep, voffB); PG8_STAGE(PG8_SA(0, 0), a2, voffA);
            PG8_WAIT_V(8); PG8_WAIT_L(0); PG8_BAR; PG8_MMA(1, 0, At, B0); PG8_MMA(1, 1, At, B1); PG8_BAR; PG8_SCHED;
            PG8_LDB(B0, 1, 0); PG8_LDB(B1, 1, 1); PG8_SCHED; PG8_LDA(At, 1, 0); PG8_STAGE(PG8_SA(0, 1), a2 + hstep, voffA);
            PG8_WAIT_V(8); PG8_WAIT_L(0); PG8_BAR; PG8_MMA(0, 0, At, B0); PG8_MMA(0, 1, At, B1); PG8_BAR; PG8_SCHED;
            PG8_LDA(At, 1, 1); PG8_STAGE(PG8_SB(1, 0), b3, voffB); PG8_STAGE(PG8_SB(1, 1), b3 + hstep, voffB); PG8_STAGE(PG8_SA(1, 0), a3, voffA);
            PG8_WAIT_V(8); PG8_WAIT_L(0); PG8_BAR; PG8_MMA(1, 0, At, B0); PG8_MMA(1, 1, At, B1); PG8_BAR; PG8_SCHED;
            } else {
            PG8_LDB(B0, 0, 0); PG8_SCHED; PG8_LDA(At, 0, 0); PG8_STAGE(PG8_SA(1, 1), a1 + hstep, voffA);
            PG8_WAIT_L(8); PG8_BAR; PG8_WAIT_L(0); PG8_MMA(0, 0, At, B0); PG8_BAR; PG8_SCHED;
            PG8_LDB(B1, 0, 1); PG8_STAGE(PG8_SB(0, 0), b2, voffB);
            PG8_BAR; PG8_WAIT_L(0); PG8_MMA(0, 1, At, B1); PG8_BAR;
            PG8_LDA(At, 0, 1); PG8_STAGE(PG8_SA(0, 0), a2, voffA);
            PG8_BAR; PG8_WAIT_L(0); PG8_MMA(1, 0, At, B0); PG8_BAR; PG8_SCHED;
            PG8_STAGE(PG8_SB(0, 1), b2 + hstep, voffB);
            PG8_WAIT_V(6); PG8_BAR; PG8_MMA(1, 1, At, B1); PG8_BAR;
            PG8_LDB(B0, 1, 0); PG8_SCHED; PG8_LDA(At, 1, 0); PG8_STAGE(PG8_SA(0, 1), a2 + hstep, voffA);
            PG8_WAIT_L(8); PG8_BAR; PG8_WAIT_L(0); PG8_MMA(0, 0, At, B0); PG8_BAR; PG8_SCHED;
            PG8_LDB(B1, 1, 1); PG8_STAGE(PG8_SB(1, 0), b3, voffB);
            PG8_BAR; PG8_WAIT_L(0); PG8_MMA(0, 1, At, B1); PG8_BAR;
            PG8_LDA(At, 1, 1); PG8_STAGE(PG8_SA(1, 0), a3, voffA);
            PG8_BAR; PG8_WAIT_L(0); PG8_MMA(1, 0, At, B0); PG8_BAR; PG8_SCHED;
            PG8_STAGE(PG8_SB(1, 1), b3 + hstep, voffB);
            PG8_WAIT_V(6); PG8_BAR; PG8_MMA(1, 1, At, B1); PG8_BAR;
            }
        }
        if constexpr (ALIGN_EPI) { if (wr == 0) PG8_BAR; }
        { int fr_ = fr, fq_ = fq; asm volatile("" : "+v"(fr_), "+v"(fq_)); E(acc, cur, wr, wc, fr_, fq_); }
        if (!has_next) break;
        if (E.zero_after(cur)) {
#pragma unroll
        for (int a = 0; a < 2; ++a)
#pragma unroll
            for (int b = 0; b < 2; ++b)
#pragma unroll
                for (int m = 0; m < 4; ++m)
#pragma unroll
                    for (int n = 0; n < 2; ++n) acc[a][b][m][n] = (f32x4){0.f, 0.f, 0.f, 0.f};
        }
        cur = nxt; cA = nA; cB = nB; ++ui;
        if constexpr (ALIGN_EPI) { if (wr == 1) PG8_BAR; }
    }
    PG8_WAIT_V(0);
    if constexpr (!ALIGN_EPI) { if (wr == 0) PG8_BAR; }
    PG8_BAR;
#undef PG8_SA
#undef PG8_SB
#undef PG8_STAGE
#undef PG8_LDA
#undef PG8_LDB
#undef PG8_MMA
#undef PG8_WAIT_V
#undef PG8_WAIT_L
#undef PG8_BAR
#undef PG8_SCHED
}
}
using pg8::Unit;

struct SchedPlain { int nM, nN, G, c;
    __device__ __forceinline__ bool next(int i, Unit& u) const { const long L = (long)i * G + c; if (L >= (long)nM * nN) return false; pg8::static_map((int)L, nM, nN, u); return true; } };
struct SchedIn { int G, c;
    __device__ __forceinline__ bool next(int i, Unit& u) const { const long L = (long)i * G + c; if (L >= 1400) return false;
        if (L < 1344) pg8::static_map((int)L, 64, 21, u); else { const int e = (int)L - 1344; u.pm = 64 + (e & 7); u.pn = e >> 3; } return true; } };
struct SchedInA { int G, c;
    __device__ __forceinline__ bool next(int i, Unit& u) const { const long L = (long)i * G + c; if (L >= 760) return false;
        if (L < 704) { pg8::static_map((int)L, 64, 11, u); u.pn = u.pn < 9 ? u.pn : u.pn + 2; } else { const int e = (int)L - 704; u.pm = 64 + (e & 7); u.pn = e >> 3; } return true; } };
struct SchedInB { int G, c;
    __device__ __forceinline__ bool next(int i, Unit& u) const { const long L = (long)i * G + c; if (L >= 640) return false;
        pg8::static_map((int)L, 64, 10, u); u.pn = u.pn < 2 ? u.pn + 9 : u.pn + 11; return true; } };
struct SchedPair { int G, c;
    __device__ __forceinline__ bool next(int i, Unit& u) const { const long L = (long)(i >> 1) * G + c; if (L >= 256) return false; pg8::static_map((int)L, 64, 4, u); if (i & 1) { u.pm += 64; u.pn += 4; } return true; } };

__host__ __device__ __forceinline__ int in_src_col(int n) {
    const int pn = n >> 8, pc = n & 255;
    if (pn == 6 || pn == 11 || pn == 12) {
        const int bj = pc >> 7, wc = (pc >> 5) & 3, fq = (pc >> 3) & 3, nn = (pc >> 2) & 1, j = pc & 3;
        if (pn == 6) { if (wc < 2) return 1536 + 64 * wc + 32 * bj + 16 * nn + 4 * fq + j; return 1664 + 64 * (wc - 2) + 32 * bj + 8 * fq + 4 * nn + j; }
        return 2816 + 64 * (4 * (pn - 11) + wc) + 32 * bj + 16 * nn + 4 * fq + j;
    }
    if (pn >= 13) return 3328 + (((n & 255) >> 7) ? 1024 : 0) + 128 * (pn - 13) + (n & 127);
    return n;
}

struct EpiIn {
    static constexpr bool PERM = true;
    half_t* lf; bf16_t *inp, *kv, *qhg, *ghg, *qat, *gates; const float *lbt, *rcos, *rsin, *qnw, *knw;
    __device__ __forceinline__ bool zero_after(const Unit&) const { return true; }
    __device__ __forceinline__ void head_norm_rope(f32x4 (&acc)[2][2][4][2], int ai, int m, int row, int fq, const float* nw, bool rope, float scale, bf16_t* dst) const {
        float ss = 0.f;
#pragma unroll
        for (int bj = 0; bj < 2; ++bj)
#pragma unroll
            for (int n = 0; n < 2; ++n) { const f32x4 v = acc[ai][bj][m][n]; ss += (v[0] * v[0] + v[1] * v[1]) + (v[2] * v[2] + v[3] * v[3]); }
        ss += __shfl_xor(ss, 16); ss += __shfl_xor(ss, 32);
        const float rinv = rsqrtf(ss * (1.f / 64.f) + EPSN) * scale;
        const int t = row & 2047;
#pragma unroll
        for (int bj = 0; bj < 2; ++bj) {
            const int pos = bj ? (t & 63) : (t >> 6);
            const f32x4 w0 = *(const f32x4*)(nw + 32 * bj + 4 * fq), w1 = *(const f32x4*)(nw + 32 * bj + 16 + 4 * fq);
            const f32x4 t1 = acc[ai][bj][m][0] * rinv * w0, t2 = acc[ai][bj][m][1] * rinv * w1;
            f32x4 o1 = t1, o2 = t2;
            if (rope) { const f32x4 cs = *(const f32x4*)(rcos + pos * 16 + 4 * fq), sn = *(const f32x4*)(rsin + pos * 16 + 4 * fq); o1 = t1 * cs - t2 * sn; o2 = t1 * sn + t2 * cs; }
            *(u32x4*)(dst + 32 * bj + 8 * fq) = pack8(o1, o2);
        }
    }
    __device__ __forceinline__ void operator()(f32x4 (&acc)[2][2][4][2], const Unit& u, int wr, int wc, int fr, int fq) const {
        const int pn = u.pn, rbase = u.pm * 256 + wr * 64 + fr;
        if (pn < 4) {
#pragma unroll
            for (int bj = 0; bj < 2; ++bj) {
                const int col = pn * 256 + bj * 128 + wc * 32 + 8 * fq;
                const f32x4 lb0 = *(const f32x4*)(lbt + col), lb1 = *(const f32x4*)(lbt + col + 4);
#pragma unroll
                for (int ai = 0; ai < 2; ++ai)
#pragma unroll
                    for (int m = 0; m < 4; ++m) {
                        const int row = rbase + ai * 128 + m * 16; const f32x4 v0 = acc[ai][bj][m][0], v1 = acc[ai][bj][m][1]; f32x4 o0, o1;
#pragma unroll
                        for (int j = 0; j < 4; ++j) { o0[j] = __builtin_amdgcn_logf(lb0[j] + (1.f - lb0[j]) * sigm(v0[j])); o1[j] = __builtin_amdgcn_logf(lb1[j] + (1.f - lb1[j]) * sigm(v1[j])); }
                        u32x4 hw; hw.x = cvt_pk_f16(o0[0], o0[1]); hw.y = cvt_pk_f16(o0[2], o0[3]); hw.z = cvt_pk_f16(o1[0], o1[1]); hw.w = cvt_pk_f16(o1[2], o1[3]); *(u32x4*)(lf + ((((size_t)(row >> 5) * 8 + (col >> 7)) * 32 + (row & 31)) * 128 + (col & 127))) = hw;
                    }
            }
        } else if (pn == 6) {
#pragma unroll
            for (int ai = 0; ai < 2; ++ai)
#pragma unroll
                for (int m = 0; m < 4; ++m) {
                    const int row = rbase + ai * 128 + m * 16; bf16_t* d = kv + (size_t)row * 256 + wc * 64;
                    if (wc < 2) head_norm_rope(acc, ai, m, row, fq, knw, u.pm < 64, 1.f, d);
                    else {
#pragma unroll
                        for (int bj = 0; bj < 2; ++bj) *(u32x4*)(d + 32 * bj + 8 * fq) = pack8(acc[ai][bj][m][0], acc[ai][bj][m][1]);
                    }
                }
        } else if (pn == 11 || pn == 12) {
#pragma unroll
            for (int ai = 0; ai < 2; ++ai)
#pragma unroll
                for (int m = 0; m < 4; ++m) { const int row = rbase + ai * 128 + m * 16;
                    head_norm_rope(acc, ai, m, row, fq, qnw, true, 0.125f * 1.4426950408889634f, qat + (size_t)row * 512 + (4 * (pn - 11) + wc) * 64); }
        } else if (pn < 6) plain_tile<0, true>(acc, inp, 512, pn - 4, rbase, wc, fq);
        else if (pn < 9) plain_tile<1, true>(acc, qhg, 512, pn - 7, rbase, wc, fq);
        else if (pn < 11) plain_tile<2>(acc, ghg, 512, pn - 9, rbase, wc, fq);
        else {
            const int cb = (pn - 13) * 128 + wc * 32 + 8 * fq;
#pragma unroll
            for (int ai = 0; ai < 2; ++ai)
#pragma unroll
                for (int m = 0; m < 4; ++m) { const int row = rbase + ai * 128 + m * 16; f32x4 r0, r1, a0, a1;
#pragma unroll
                    for (int j = 0; j < 4; ++j) { const float eh0 = __expf(-acc[ai][0][m][0][j]), eh1 = __expf(-acc[ai][0][m][1][j]), ea0 = __expf(-acc[ai][1][m][0][j]), ea1 = __expf(-acc[ai][1][m][1][j]);
                        a0[j] = __builtin_amdgcn_rcpf(1.f + ea0); a1[j] = __builtin_amdgcn_rcpf(1.f + ea1);
                        r0[j] = (1.f + ea0) * __builtin_amdgcn_rcpf(1.f + eh0); r1[j] = (1.f + ea1) * __builtin_amdgcn_rcpf(1.f + eh1); }
                    *(u32x4*)(gates + (size_t)row * 2048 + cb) = pack8(r0, r1); *(u32x4*)(gates + (size_t)row * 2048 + 1024 + cb) = pack8(a0, a1); asm volatile("" ::: "memory"); }
        }
    }
    template <int ACT, bool BLK = false>
    __device__ __forceinline__ void plain_tile(f32x4 (&acc)[2][2][4][2], bf16_t* base, int ld, int ct, int rbase, int wc, int fq) const {
#pragma unroll
        for (int ai = 0; ai < 2; ++ai)
#pragma unroll
            for (int m = 0; m < 4; ++m) { const int row = rbase + ai * 128 + m * 16;
#pragma unroll
                for (int bj = 0; bj < 2; ++bj) { f32x4 v0 = acc[ai][bj][m][0], v1 = acc[ai][bj][m][1];
                    if (ACT) {
#pragma unroll
                        for (int j = 0; j < 4; ++j) { const float s0 = sigm(v0[j]), s1 = sigm(v1[j]);
                            if (ACT == 3) { v0[j] = s0; v1[j] = s1; } else { const float sc = ACT == 1 ? 0.08838834764831845f : 1.f; v0[j] = v0[j] * s0 * sc; v1[j] = v1[j] * s1 * sc; } } }
                    *(u32x4*)(base + (BLK ? ((((size_t)(row >> 5) * 4 + (ct * 2 + bj)) * 32 + (row & 31)) * 128 + wc * 32 + 8 * fq) : ((size_t)row * ld + ct * 256 + bj * 128 + wc * 32 + 8 * fq))) = pack8(v0, v1); asm volatile("" ::: "memory"); } }
    }
};

struct EpiBranch {
    static constexpr bool TWICE = false;
    static constexpr bool PERM = true;
    const bf16_t* gates; bf16_t* mixed;
    __device__ __forceinline__ bool zero_after(const Unit&) const { return false; }
    __device__ __forceinline__ void operator()(f32x4 (&acc)[2][2][4][2], const Unit& u, int wr, int wc, int fr, int fq) const {
        const bool second = u.pm >= 64; const int rbase = (u.pm & 63) * 256 + wr * 64 + fr, cbase = (u.pn & 3) * 256 + wc * 32 + 8 * fq;
#pragma unroll
        for (int ai = 0; ai < 2; ++ai)
#pragma unroll
            for (int m = 0; m < 4; ++m) { const int row = rbase + ai * 128 + m * 16;
#pragma unroll
                for (int bj = 0; bj < 2; ++bj) { const int col = cbase + bj * 128;
                    const u32x4 gq = *(const u32x4*)(gates + (size_t)row * 2048 + (second ? 1024 : 0) + col);
                    const f32x4 g0 = {bf_lo(gq.x), bf_hi(gq.x), bf_lo(gq.y), bf_hi(gq.y)}, g1 = {bf_lo(gq.z), bf_hi(gq.z), bf_lo(gq.w), bf_hi(gq.w)};
                    if (!second) { acc[ai][bj][m][0] *= g0; acc[ai][bj][m][1] *= g1; }
                    else { *(u32x4*)(mixed + (size_t)row * 1024 + col) = pack8(acc[ai][bj][m][0] * g0, acc[ai][bj][m][1] * g1); acc[ai][bj][m][0] = (f32x4){0.f, 0.f, 0.f, 0.f}; acc[ai][bj][m][1] = (f32x4){0.f, 0.f, 0.f, 0.f}; }
                } }
    }
};

struct EpiRes {
    static constexpr bool PERM = true;
    const float* xin; const float* g; float* dst;
    __device__ __forceinline__ bool zero_after(const Unit&) const { return true; }
    __device__ __forceinline__ void operator()(f32x4 (&acc)[2][2][4][2], const Unit& u, int wr, int wc, int fr, int fq) const {
        const int rbase = u.pm * 256 + wr * 64 + fr, cbase = u.pn * 256 + wc * 32 + 8 * fq; const float* gb = g + (size_t)(u.pm >> 3) * 6144;
#pragma unroll
        for (int bj = 0; bj < 2; ++bj) { const int col = cbase + bj * 128; const f32x4 g0 = *(const f32x4*)(gb + col), g1 = *(const f32x4*)(gb + col + 4);
#pragma unroll
            for (int ai = 0; ai < 2; ++ai)
#pragma unroll
                for (int m = 0; m < 4; ++m) { const size_t o = (size_t)(rbase + ai * 128 + m * 16) * 1024 + col;
                    const f32x4 x0 = *(const f32x4*)(xin + o), x1 = *(const f32x4*)(xin + o + 4);
                    *(f32x4*)(dst + o) = x0 + g0 * acc[ai][bj][m][0]; *(f32x4*)(dst + o + 4) = x1 + g1 * acc[ai][bj][m][1]; } }
    }
};

struct EpiGU {
    static constexpr bool TWICE = false;
    static constexpr bool PERM = true;
    bf16_t* act;
    __device__ __forceinline__ bool zero_after(const Unit&) const { return true; }
    __device__ __forceinline__ void operator()(f32x4 (&acc)[2][2][4][2], const Unit& u, int wr, int wc, int fr, int fq) const {
        const int rbase = u.pm * 256 + wr * 64 + fr, cbase = u.pn * 128 + wc * 32 + 8 * fq;
#pragma unroll
        for (int ai = 0; ai < 2; ++ai)
#pragma unroll
            for (int m = 0; m < 4; ++m) { f32x4 r0, r1;
#pragma unroll
                for (int j = 0; j < 4; ++j) { const float g0 = acc[ai][0][m][0][j], g1 = acc[ai][0][m][1][j]; r0[j] = g0 * sigm(g0) * acc[ai][1][m][0][j]; r1[j] = g1 * sigm(g1) * acc[ai][1][m][1][j]; }
                *(u32x4*)(act + (size_t)(rbase + ai * 128 + m * 16) * 2816 + cbase) = pack8(r0, r1); }
    }
};

#define WSP(T, off) ((T*)(p.ws + (off)))

__device__ __forceinline__ void mod_item(const Params& p, int item, LAS float* lds) {
    const int t = tid_(), cg = t & 15, kr = t >> 4;
    for (int i = t; i < 9 * 1024; i += 512) { const int r = i >> 10, k = i & 1023; const float v = r < 8 ? p.c[r * 1024 + k] : p.c_ctx[k]; lds[i] = v * sigm(v); }
    __syncthreads();
    f32x4 a0 = {0.f, 0.f, 0.f, 0.f}, a1 = a0, a2 = a0, a3 = a0, a4 = a0, a5 = a0, a6 = a0, a7 = a0, a8 = a0;
    const float* wp = p.w_ada + (size_t)kr * 6144 + item * 64 + cg * 4;
#pragma unroll 8
    for (int it = 0; it < 32; ++it) { const int k = kr + 32 * it; const f32x4 w = __builtin_nontemporal_load((const f32x4*)(wp + (size_t)it * 32 * 6144));
        a0 += w * lds[k]; a1 += w * lds[1024 + k]; a2 += w * lds[2048 + k]; a3 += w * lds[3072 + k]; a4 += w * lds[4096 + k]; a5 += w * lds[5120 + k]; a6 += w * lds[6144 + k]; a7 += w * lds[7168 + k]; a8 += w * lds[8192 + k]; }
    LAS float* red = lds + 9 * 1024;
    *(LAS f32x4*)(red + ((kr * 9 + 0) * 64 + cg * 4)) = a0; *(LAS f32x4*)(red + ((kr * 9 + 1) * 64 + cg * 4)) = a1; *(LAS f32x4*)(red + ((kr * 9 + 2) * 64 + cg * 4)) = a2;
    *(LAS f32x4*)(red + ((kr * 9 + 3) * 64 + cg * 4)) = a3; *(LAS f32x4*)(red + ((kr * 9 + 4) * 64 + cg * 4)) = a4; *(LAS f32x4*)(red + ((kr * 9 + 5) * 64 + cg * 4)) = a5;
    *(LAS f32x4*)(red + ((kr * 9 + 6) * 64 + cg * 4)) = a6; *(LAS f32x4*)(red + ((kr * 9 + 7) * 64 + cg * 4)) = a7; *(LAS f32x4*)(red + ((kr * 9 + 8) * 64 + cg * 4)) = a8;
    __syncthreads();
    for (int idx = t; idx < 576; idx += 512) { const int r = idx >> 6, cc = idx & 63; float s_ = 0.f;
#pragma unroll 8
        for (int q = 0; q < 32; ++q) s_ += red[(q * 9 + r) * 64 + cc];
        WSP(float, OFF_MOD)[r * 6144 + item * 64 + cc] = s_ + p.b_ada[item * 64 + cc]; }
    __syncthreads();
}

__device__ __forceinline__ void tables_item(const Params& p) {
    const int t = tid_(); float* tab = WSP(float, OFF_TAB);
    for (int i = t; i < 1024; i += 512) { const int pos = i >> 4, f = i & 15; const float inv = powf(10000.f, -(float)f / 16.f), ang = (float)pos * inv; tab[i] = cosf(ang); tab[1024 + i] = sinf(ang); }
    for (int i = t; i < 1024; i += 512) { const int dir = i >> 9, ch = i & 511; const float l0 = p.lb_logits[dir * 1024 + ch], l1 = p.lb_logits[dir * 1024 + 512 + ch]; tab[2048 + i] = 1.f / (1.f + expf(l1 - l0)); }
}

__device__ __forceinline__ void conv_item(const Params& p, int it, LAS float* tile) {
    const float* W; const float* W2 = nullptr; int ldw, K, ntl, kind = 0; bf16_t* dst;
    if (it < 336) { W = p.w_in; ldw = 5376; K = 1024; dst = WSP(bf16_t, OFF_WIN); kind = 1; ntl = 84; }
    else if ((it -= 336) < 32) { W = p.w_bh; ldw = 1024; K = 512; dst = WSP(bf16_t, OFF_WB); ntl = 16; }
    else if ((it -= 32) < 32) { W = p.w_ba; ldw = 1024; K = 512; dst = WSP(bf16_t, OFF_WB) + (size_t)1024 * 512; ntl = 16; }
    else if ((it -= 32) < 64) { W = p.w_out; ldw = 1024; K = 1024; dst = WSP(bf16_t, OFF_WOUT); ntl = 16; }
    else if ((it -= 64) < 352) { W = p.w_gate; W2 = p.w_up; ldw = 2816; K = 1024; dst = WSP(bf16_t, OFF_WGU); kind = 2; ntl = 88; }
    else { it -= 352; W = p.w_dn; ldw = 1024; K = 2816; dst = WSP(bf16_t, OFF_WDN); ntl = 16; }
    const int n0 = (it % ntl) * 64, k0 = (it / ntl) * 256, t = tid_();
    { const int nn = t & 63, kq = t >> 6, n = n0 + nn; int col = n; const float* src = W;
      if (kind == 1) col = in_src_col(n);
      else if (kind == 2) { const int pn = n >> 8, pc = n & 255, bj = pc >> 7, wc = (pc >> 5) & 3, fq = (pc >> 3) & 3, nb = (pc >> 2) & 1, j = pc & 3; col = 128 * pn + 32 * wc + 8 * fq + 4 * nb + j; if (bj) src = W2; }
      float v[32];
#pragma unroll
      for (int i = 0; i < 32; ++i) v[i] = __builtin_nontemporal_load(src + (size_t)(k0 + kq * 32 + i) * ldw + col);
#pragma unroll
      for (int i = 0; i < 32; ++i) tile[(kq * 32 + i) * 65 + nn] = v[i]; }
    __syncthreads();
#pragma unroll
    for (int h = 0; h < 4; ++h) { const int k8 = (t & 7) + 8 * h, n2 = t >> 3; const LAS float* s = tile + (k8 * 8) * 65 + n2;
      u32x4 o; o.x = cvt_pk_bf16(s[0], s[65]); o.y = cvt_pk_bf16(s[130], s[195]); o.z = cvt_pk_bf16(s[260], s[325]); o.w = cvt_pk_bf16(s[390], s[455]);
      *(u32x4*)(dst + (size_t)(n0 + n2) * K + k0 + k8 * 8) = o; }
    __syncthreads();
}

__device__ __forceinline__ void norm_phase(const Params& p, const float* xlat, const float* xctx, int nrows, const float* nw, int sh_off, int sc_off, bf16_t* dst) {
    const int tt = tid_(), lane = tt & 63, gw = blockIdx.x * 8 + (tt >> 6), ngw = gridDim.x * 8; const float* mod = WSP(float, OFF_MOD);
    f32x4 c0, c1, c2, c3;
    { const int r = gw; const float* xr = r < MLAT ? xlat + (size_t)r * 1024 : xctx + (size_t)(r - MLAT) * 1024;
      c0 = *(const f32x4*)(xr + 4 * lane); c1 = *(const f32x4*)(xr + 4 * lane + 256); c2 = *(const f32x4*)(xr + 4 * lane + 512); c3 = *(const f32x4*)(xr + 4 * lane + 768); }
    for (int r = gw; r < nrows; r += ngw) {
        const int rn = r + ngw < nrows ? r + ngw : r; const float* xn = rn < MLAT ? xlat + (size_t)rn * 1024 : xctx + (size_t)(rn - MLAT) * 1024;
        const f32x4 n0 = *(const f32x4*)(xn + 4 * lane), n1 = *(const f32x4*)(xn + 4 * lane + 256), n2 = *(const f32x4*)(xn + 4 * lane + 512), n3 = *(const f32x4*)(xn + 4 * lane + 768);
        const float* mr = mod + (size_t)(r < MLAT ? (r >> 11) : 8) * 6144;
        float ss = (c0[0] * c0[0] + c0[1] * c0[1]) + (c0[2] * c0[2] + c0[3] * c0[3]) + (c1[0] * c1[0] + c1[1] * c1[1]) + (c1[2] * c1[2] + c1[3] * c1[3])
                 + (c2[0] * c2[0] + c2[1] * c2[1]) + (c2[2] * c2[2] + c2[3] * c2[3]) + (c3[0] * c3[0] + c3[1] * c3[1]) + (c3[2] * c3[2] + c3[3] * c3[3]);
#pragma unroll
        for (int o = 1; o < 64; o <<= 1) ss += __shfl_xor(ss, o);
        const float rinv = rsqrtf(ss * (1.f / 1024.f) + EPSN);
        f32x4 v[4] = {c0, c1, c2, c3};
#pragma unroll
        for (int i = 0; i < 4; ++i) { const int ch = 4 * lane + 256 * i; const f32x4 w = *(const f32x4*)(nw + ch), sh = *(const f32x4*)(mr + sh_off + ch), sc = *(const f32x4*)(mr + sc_off + ch);
            const f32x4 y = v[i] * rinv * w * (sc + 1.f) + sh; u32x2 o; o.x = cvt_pk_bf16(y[0], y[1]); o.y = cvt_pk_bf16(y[2], y[3]); *(u32x2*)(dst + (size_t)r * 1024 + ch) = o; }
        c0 = n0; c1 = n1; c2 = n2; c3 = n3;
    }
}

__device__ __forceinline__ void hgrn_item_simple(const Params& p, int item, LAS float* lds) {
    const int t = tid_(), dv = t & 127, kq = t >> 7, dir = item & 1, h = (item >> 1) & 3, b = item >> 3;
    const half_t* lf = WSP(half_t, OFF_LF); const bf16_t* inp = WSP(bf16_t, OFF_INP); const bf16_t* qhg = WSP(bf16_t, OFF_QHG);
    bf16_t* od = (bf16_t*)((unsigned char*)p.out + (dir ? OUT_OB : OUT_OF));
    LAS float* fS = lds; LAS float* qS = lds + 2048; LAS float* vS = lds + 4096; LAS float* red = lds + 6144;
    float S[32];
#pragma unroll
    for (int i = 0; i < 32; ++i) S[i] = 0.f;
    for (int g = 0; g < 144; ++g) {
        const bool lat = g >= 16;
#pragma unroll
        for (int i = 0; i < 4; ++i) { const int pp = 4 * kq + i, sp = 16 * g + pp; int row;
            if (!lat) row = MLAT + b * 256 + (dir ? 255 - sp : sp); else { const int lt = sp - 256; row = b * 2048 + (dir ? 2047 - lt : lt); }
            fS[pp * 128 + dv] = __builtin_amdgcn_exp2f((float)lf[(size_t)row * 1024 + dir * 512 + h * 128 + dv]);
            qS[pp * 128 + dv] = lat ? bf2f(qhg[(size_t)row * 512 + h * 128 + dv]) : 0.f;
            vS[pp * 128 + dv] = bf2f(inp[(size_t)row * 512 + h * 128 + dv]); }
        __syncthreads();
        for (int pp = 0; pp < 16; ++pp) { const float v = vS[pp * 128 + dv]; float part = 0.f;
#pragma unroll
            for (int kk = 0; kk < 32; ++kk) { const float f = fS[pp * 128 + kq * 32 + kk]; S[kk] = f * S[kk] + (1.f - f) * v; part += S[kk] * qS[pp * 128 + kq * 32 + kk]; }
            red[(pp * 4 + kq) * 128 + dv] = part; }
        __syncthreads();
        if (lat) {
#pragma unroll
            for (int i = 0; i < 4; ++i) { const int idx = t + 512 * i, pp = idx >> 7, d2 = idx & 127, lt = 16 * g + pp - 256, row = b * 2048 + (dir ? 2047 - lt : lt);
                const float o = (red[(pp * 4 + 0) * 128 + d2] + red[(pp * 4 + 1) * 128 + d2]) + (red[(pp * 4 + 2) * 128 + d2] + red[(pp * 4 + 3) * 128 + d2]);
                od[(size_t)row * 512 + h * 128 + d2] = f2bf(o); }
        }
    }
    __syncthreads();
}

__device__ __forceinline__ void attn_item_simple(const Params& p, int item, LAS unsigned* lds) {
    const int t = tid_(), g = t >> 7, qi = t & 127, qb = item & 15, kvh = (item >> 4) & 1, b = item >> 5, hq = kvh * 4 + g, tq = qb * 128 + qi;
    const bf16_t* kv = WSP(bf16_t, OFF_KV); const bf16_t* qat = WSP(bf16_t, OFF_QAT); bf16_t* yat = WSP(bf16_t, OFF_QAT);
    float q[64], o[64];
    { const u32x4* qp = (const u32x4*)(qat + (size_t)(b * 2048 + tq) * 512 + hq * 64);
#pragma unroll
      for (int i = 0; i < 8; ++i) { const u32x4 w = qp[i]; q[8 * i] = bf_lo(w.x); q[8 * i + 1] = bf_hi(w.x); q[8 * i + 2] = bf_lo(w.y); q[8 * i + 3] = bf_hi(w.y); q[8 * i + 4] = bf_lo(w.z); q[8 * i + 5] = bf_hi(w.z); q[8 * i + 6] = bf_lo(w.w); q[8 * i + 7] = bf_hi(w.w); } }
#pragma unroll
    for (int i = 0; i < 64; ++i) o[i] = 0.f;
    float mx = p.sinks[hq], l = 1.f;
    LAS unsigned* Ks = lds; LAS unsigned* Vs = lds + 2048;
    for (int tile = 0; tile < 10; ++tile) {
        const bool isctx = tile >= 6; const int ks = isctx ? (tile - 6) * 64 : 128 * (qb - 1) + 64 * tile;
        if (!isctx && (ks < 0 || ks >= 2048)) continue;
        { const int key = t >> 3, part = t & 7; const size_t row = isctx ? (size_t)(MLAT + b * 256 + ks + key) : (size_t)(b * 2048 + ks + key);
          *(LAS u32x4*)(Ks + key * 32 + part * 4) = *(const u32x4*)(kv + row * 256 + kvh * 64 + part * 8);
          *(LAS u32x4*)(Vs + key * 32 + part * 4) = *(const u32x4*)(kv + row * 256 + 128 + kvh * 64 + part * 8); }
        __syncthreads();
        for (int key = 0; key < 64; ++key) {
            float s = 0.f;
#pragma unroll
            for (int i = 0; i < 8; ++i) { const u32x4 w = *(const LAS u32x4*)(Ks + key * 32 + i * 4);
                s += q[8 * i] * bf_lo(w.x) + q[8 * i + 1] * bf_hi(w.x) + q[8 * i + 2] * bf_lo(w.y) + q[8 * i + 3] * bf_hi(w.y) + q[8 * i + 4] * bf_lo(w.z) + q[8 * i + 5] * bf_hi(w.z) + q[8 * i + 6] * bf_lo(w.w) + q[8 * i + 7] * bf_hi(w.w); }
            const int dlt = tq - (ks + key); const bool valid = isctx || (dlt <= 128 && dlt >= -128);
            if (valid) {
                const float mn = fmaxf(mx, s), al = __expf(mx - mn), pe = __expf(s - mn); l = l * al + pe; mx = mn;
#pragma unroll
                for (int i = 0; i < 8; ++i) { const u32x4 w = *(const LAS u32x4*)(Vs + key * 32 + i * 4);
                    o[8 * i] = o[8 * i] * al + pe * bf_lo(w.x); o[8 * i + 1] = o[8 * i + 1] * al + pe * bf_hi(w.x); o[8 * i + 2] = o[8 * i + 2] * al + pe * bf_lo(w.y); o[8 * i + 3] = o[8 * i + 3] * al + pe * bf_hi(w.y);
                    o[8 * i + 4] = o[8 * i + 4] * al + pe * bf_lo(w.z); o[8 * i + 5] = o[8 * i + 5] * al + pe * bf_hi(w.z); o[8 * i + 6] = o[8 * i + 6] * al + pe * bf_lo(w.w); o[8 * i + 7] = o[8 * i + 7] * al + pe * bf_hi(w.w); }
            }
        }
        __syncthreads();
    }
    const float il = 1.f / l; u32x4* yp = (u32x4*)(yat + (size_t)(b * 2048 + tq) * 512 + hq * 64);
#pragma unroll
    for (int i = 0; i < 8; ++i) { u32x4 w; w.x = cvt_pk_bf16(o[8 * i] * il, o[8 * i + 1] * il); w.y = cvt_pk_bf16(o[8 * i + 2] * il, o[8 * i + 3] * il); w.z = cvt_pk_bf16(o[8 * i + 4] * il, o[8 * i + 5] * il); w.w = cvt_pk_bf16(o[8 * i + 6] * il, o[8 * i + 7] * il); yp[i] = w; }
}


#define LDS_BARRIER() do { asm volatile("s_waitcnt lgkmcnt(0)" ::: "memory"); __builtin_amdgcn_s_barrier(); asm volatile("" ::: "memory"); } while (0)
__device__ __forceinline__ void hgrn_item(const Params& p, int item, LAS unsigned char* lds) {
    const int t = tid_(), lane0 = t & 63, w = __builtin_amdgcn_readfirstlane(t >> 6);
    const int dir = item & 1, h = (item >> 1) & 3, b = item >> 3;
    const half_t* lf = WSP(const half_t, OFF_LF) + (size_t)(dir * 4 + h) * 4096;
    const bf16_t* inp = WSP(const bf16_t, OFF_INP) + (size_t)h * 4096;
    const bf16_t* qhg = WSP(const bf16_t, OFF_QHG) + (size_t)h * 4096;
    bf16_t* od = (bf16_t*)((unsigned char*)p.out + (dir ? OUT_OB : OUT_OF)) + h * 128;
    constexpr int SETB = 38400, QD = 0, KD = 8704, KUT = 17408, VT = 27648, DEC = 37888, PP = 76800, QS = 79360, RING = 80896, SLOT = 24576, RQ = 8192, RV = 16384;
    const int pw = w & 3, kh = pw & 1, ph = pw >> 1;
#define HG_RB(cs) ((cs) < 8 ? MLAT + b * 256 + (dir ? 7 - (cs) : (cs)) * 32 : b * 2048 + (dir ? 71 - (cs) : (cs) - 8) * 32)
#define HG_POS(pos) (dir ? 31 - (pos) : (pos))
#define HG_DMA(cs_, slot_) do { const int cc_ = (cs_) < 71 ? (cs_) : 71, rb_ = HG_RB(cc_), qb_ = cc_ >= 8 ? rb_ : 0; LAS unsigned char* sl_ = lds + RING + (slot_) * SLOT; \
        const unsigned char* bl_ = (const unsigned char*)lf + (size_t)(rb_ >> 5) * 65536; const unsigned char* bq_ = (const unsigned char*)qhg + (size_t)(qb_ >> 5) * 32768; const unsigned char* bv_ = (const unsigned char*)inp + (size_t)(rb_ >> 5) * 32768; \
        __builtin_amdgcn_global_load_lds((const unsigned*)(bl_ + dof[0]), (LAS unsigned*)(sl_ + pw * 2048), 16, 0, 2); __builtin_amdgcn_global_load_lds((const unsigned*)(bl_ + dof[1]), (LAS unsigned*)(sl_ + pw * 2048 + 1024), 16, 0, 2); \
        __builtin_amdgcn_global_load_lds((const unsigned*)(bq_ + dof[2]), (LAS unsigned*)(sl_ + RQ + pw * 2048), 16, 0, 2); __builtin_amdgcn_global_load_lds((const unsigned*)(bq_ + dof[3]), (LAS unsigned*)(sl_ + RQ + pw * 2048 + 1024), 16, 0, 2); \
        __builtin_amdgcn_global_load_lds((const unsigned*)(bv_ + dof[4]), (LAS unsigned*)(sl_ + RV + pw * 2048), 16, 0, 2); __builtin_amdgcn_global_load_lds((const unsigned*)(bv_ + dof[5]), (LAS unsigned*)(sl_ + RV + pw * 2048 + 1024), 16, 0, 2); } while (0)
    f32x4 S[8][2];
#pragma unroll
    for (int i = 0; i < 8; ++i) { S[i][0] = (f32x4){0.f, 0.f, 0.f, 0.f}; S[i][1] = (f32x4){0.f, 0.f, 0.f, 0.f}; }
    unsigned dof[6];
    { const int lane = lane0, vp = lane & 31, vd = (lane >> 5) + 2 * pw;
#pragma unroll
      for (int j = 0; j < 2; ++j) { const int pr = HG_POS(16 * ph + 8 * j + (lane >> 3));
          dof[j] = (unsigned)(pr * 128 + 64 * kh + 8 * (lane & 7)) * 2u; dof[2 + j] = dof[j]; dof[4 + j] = (unsigned)(HG_POS(vp) * 128 + (vd + 8 * j) * 8) * 2u; }
      if (w >= 4) { HG_DMA(0, 0); HG_DMA(1, 1); HG_DMA(2, 2); } }
    float cl[16]; unsigned qv[8]; u32x4 vv0, vv1;
    { const int lane = lane0, k = 64 * kh + lane, vp = lane & 31, vd = (lane >> 5) + 2 * pw;
        if (w >= 4) {
            if (true) {
                asm volatile("s_waitcnt vmcnt(12)" ::: "memory");
                const LAS unsigned char* sl = lds + RING;
#pragma unroll
                for (int q = 0; q < 16; ++q) cl[q] = (float)*(const LAS half_t*)(sl + pw * 2048 + q * 128 + lane * 2);
#pragma unroll
                for (int q = 0; q < 8; ++q) qv[q] = (unsigned)*(const LAS bf16_t*)(sl + RQ + pw * 2048 + (2 * q) * 128 + lane * 2) | ((unsigned)*(const LAS bf16_t*)(sl + RQ + pw * 2048 + (2 * q + 1) * 128 + lane * 2) << 16);
                vv0 = *(const LAS u32x4*)(sl + RV + pw * 2048 + lane * 16); vv1 = *(const LAS u32x4*)(sl + RV + pw * 2048 + 1024 + lane * 16);
                asm volatile("s_waitcnt lgkmcnt(0)" ::: "memory");
                HG_DMA(3, 0);
#pragma unroll
                for (int q = 1; q < 16; ++q) cl[q] += cl[q - 1];
                *(LAS float*)(lds + QS + (ph * 128 + k) * 4) = cl[15];
            }
        }
      LDS_BARRIER(); }
#pragma unroll 1
    for (int i = 0; i <= 72; ++i) {
        int lane = lane0; asm volatile("" : "+v"(lane));
        const int n = lane & 15, g = lane >> 4, k = 64 * kh + lane, vp = lane & 31, vd = (lane >> 5) + 2 * pw;
        f32x4 o[2][2]; bf16x8 VB0, VB1;
        const int cs = i - 1; const bool lat = cs >= 8;
        LAS unsigned char* const cset = lds + (cs & 1) * SETB;
        LAS unsigned char* const pset = lds + (i & 1) * SETB;
        if (w >= 4) {
            if (i < 72) {
                const float q0 = *(const LAS float*)(lds + QS + k * 4), q1 = *(const LAS float*)(lds + QS + (128 + k) * 4), tot = q0 + q1, offs = ph ? q0 : 0.f;
                const float etot = __builtin_amdgcn_exp2f(tot); float einv_prev = ph ? __builtin_amdgcn_rcpf(__builtin_amdgcn_exp2f(offs)) : 1.f;
                float kuv[16];
#pragma unroll
                for (int q = 0; q < 16; ++q) { const float e = __builtin_amdgcn_exp2f(offs + cl[q]), einv = __builtin_amdgcn_rcpf(e), kk = 1.f - e * einv_prev; const int pos = 16 * ph + q;
                    *(LAS bf16_t*)(pset + QD + pos * 272 + k * 2) = f2bf(((q & 1) ? bf_hi(qv[q >> 1]) : bf_lo(qv[q >> 1])) * e);
                    *(LAS bf16_t*)(pset + KD + pos * 272 + k * 2) = f2bf(kk * einv);
                    kuv[q] = kk * einv * etot; einv_prev = einv; }
                { u32x4 kw; kw.x = cvt_pk_bf16(kuv[0], kuv[1]); kw.y = cvt_pk_bf16(kuv[2], kuv[3]); kw.z = cvt_pk_bf16(kuv[4], kuv[5]); kw.w = cvt_pk_bf16(kuv[6], kuv[7]); *(LAS u32x4*)(pset + KUT + k * 80 + ph * 32) = kw;
                  kw.x = cvt_pk_bf16(kuv[8], kuv[9]); kw.y = cvt_pk_bf16(kuv[10], kuv[11]); kw.z = cvt_pk_bf16(kuv[12], kuv[13]); kw.w = cvt_pk_bf16(kuv[14], kuv[15]); *(LAS u32x4*)(pset + KUT + k * 80 + ph * 32 + 16) = kw; }
                if (ph == 0) *(LAS float*)(pset + DEC + k * 4) = etot;
                { LAS bf16_t* vt = (LAS bf16_t*)(pset + VT + (vd * 8) * 80 + vp * 2);
                  vt[0] = (bf16_t)(vv0.x & 0xffffu); vt[40] = (bf16_t)(vv0.x >> 16); vt[80] = (bf16_t)(vv0.y & 0xffffu); vt[120] = (bf16_t)(vv0.y >> 16);
                  vt[160] = (bf16_t)(vv0.z & 0xffffu); vt[200] = (bf16_t)(vv0.z >> 16); vt[240] = (bf16_t)(vv0.w & 0xffffu); vt[280] = (bf16_t)(vv0.w >> 16);
                  vt += 64 * 40;
                  vt[0] = (bf16_t)(vv1.x & 0xffffu); vt[40] = (bf16_t)(vv1.x >> 16); vt[80] = (bf16_t)(vv1.y & 0xffffu); vt[120] = (bf16_t)(vv1.y >> 16);
                  vt[160] = (bf16_t)(vv1.z & 0xffffu); vt[200] = (bf16_t)(vv1.z >> 16); vt[240] = (bf16_t)(vv1.w & 0xffffu); vt[280] = (bf16_t)(vv1.w >> 16); }
            }
        } else if (i >= 1) {
            VB0 = *(const LAS bf16x8*)(cset + VT + (32 * w + n) * 80 + 16 * g); VB1 = *(const LAS bf16x8*)(cset + VT + (32 * w + 16 + n) * 80 + 16 * g);
#pragma unroll
            for (int a = 0; a < 2; ++a)
#pragma unroll
                for (int c2 = 0; c2 < 2; ++c2) o[a][c2] = (f32x4){0.f, 0.f, 0.f, 0.f};
            if (lat) {
                {
                    const int mb = w >> 1, nb = w & 1;
                    f32x4 sc = {0.f, 0.f, 0.f, 0.f};
                    if (w != 1) {
#pragma unroll
                        for (int s = 0; s < 4; ++s) { const bf16x8 A = *(const LAS bf16x8*)(cset + QD + (16 * mb + n) * 272 + (32 * s + 8 * g) * 2), B = *(const LAS bf16x8*)(cset + KD + (16 * nb + n) * 272 + (32 * s + 8 * g) * 2);
                            sc = __builtin_amdgcn_mfma_f32_16x16x32_bf16(A, B, sc, 0, 0, 0); }
                    }
#pragma unroll
                    for (int j = 0; j < 4; ++j) { const int c = 16 * mb + 4 * g + j, s_ = 16 * nb + n; *(LAS bf16_t*)(lds + PP + c * 80 + s_ * 2) = f2bf((w != 1 && s_ <= c) ? sc[j] : 0.f); }
                }
#pragma unroll
                for (int s = 0; s < 4; ++s) {
                    bf16x8 A[2];
#pragma unroll
                    for (int mbc = 0; mbc < 2; ++mbc) { const u32x2 lo = *(const LAS u32x2*)(cset + QD + (16 * mbc + n) * 272 + (32 * s + 4 * g) * 2), hi = *(const LAS u32x2*)(cset + QD + (16 * mbc + n) * 272 + (32 * s + 16 + 4 * g) * 2);
                        const u32x4 aw = {lo.x, lo.y, hi.x, hi.y}; A[mbc] = __builtin_bit_cast(bf16x8, aw); }
#pragma unroll
                    for (int c2 = 0; c2 < 2; ++c2) { u32x4 bw; bw.x = cvt_pk_bf16(S[2 * s][c2][0], S[2 * s][c2][1]); bw.y = cvt_pk_bf16(S[2 * s][c2][2], S[2 * s][c2][3]); bw.z = cvt_pk_bf16(S[2 * s + 1][c2][0], S[2 * s + 1][c2][1]); bw.w = cvt_pk_bf16(S[2 * s + 1][c2][2], S[2 * s + 1][c2][3]);
                        const bf16x8 B = __builtin_bit_cast(bf16x8, bw);
                        o[0][c2] = __builtin_amdgcn_mfma_f32_16x16x32_bf16(A[0], B, o[0][c2], 0, 0, 0); o[1][c2] = __builtin_amdgcn_mfma_f32_16x16x32_bf16(A[1], B, o[1][c2], 0, 0, 0); }
                }
            }
#pragma unroll
            for (int mb = 0; mb < 8; ++mb) { const f32x4 d = *(const LAS f32x4*)(cset + DEC + (16 * mb + 4 * g) * 4); const bf16x8 A = *(const LAS bf16x8*)(cset + KUT + (16 * mb + n) * 80 + 16 * g);
                S[mb][0] = __builtin_amdgcn_mfma_f32_16x16x32_bf16(A, VB0, S[mb][0] * d, 0, 0, 0); S[mb][1] = __builtin_amdgcn_mfma_f32_16x16x32_bf16(A, VB1, S[mb][1] * d, 0, 0, 0); }
        }
        LDS_BARRIER();
        if (w >= 4) {
            if (i + 1 < 72) {
                asm volatile("s_waitcnt vmcnt(12)" ::: "memory");
                const int rs_ = (i + 1) % 3; const LAS unsigned char* sl = lds + RING + rs_ * SLOT;
#pragma unroll
                for (int q = 0; q < 16; ++q) cl[q] = (float)*(const LAS half_t*)(sl + pw * 2048 + q * 128 + lane * 2);
#pragma unroll
                for (int q = 0; q < 8; ++q) qv[q] = (unsigned)*(const LAS bf16_t*)(sl + RQ + pw * 2048 + (2 * q) * 128 + lane * 2) | ((unsigned)*(const LAS bf16_t*)(sl + RQ + pw * 2048 + (2 * q + 1) * 128 + lane * 2) << 16);
                vv0 = *(const LAS u32x4*)(sl + RV + pw * 2048 + lane * 16); vv1 = *(const LAS u32x4*)(sl + RV + pw * 2048 + 1024 + lane * 16);
                asm volatile("s_waitcnt lgkmcnt(0)" ::: "memory");
                HG_DMA(i + 4, rs_);
#pragma unroll
                for (int q = 1; q < 16; ++q) cl[q] += cl[q - 1];
                *(LAS float*)(lds + QS + (ph * 128 + k) * 4) = cl[15];
            }
        } else if (i >= 1 && lat) {
            const bf16x8 A0 = *(const LAS bf16x8*)(lds + PP + n * 80 + 16 * g), A1 = *(const LAS bf16x8*)(lds + PP + (16 + n) * 80 + 16 * g);
            o[0][0] = __builtin_amdgcn_mfma_f32_16x16x32_bf16(A0, VB0, o[0][0], 0, 0, 0); o[1][0] = __builtin_amdgcn_mfma_f32_16x16x32_bf16(A1, VB0, o[1][0], 0, 0, 0);
            o[0][1] = __builtin_amdgcn_mfma_f32_16x16x32_bf16(A0, VB1, o[0][1], 0, 0, 0); o[1][1] = __builtin_amdgcn_mfma_f32_16x16x32_bf16(A1, VB1, o[1][1], 0, 0, 0);
            const int rb = HG_RB(cs), st = dir ? -512 : 512;
            bf16_t* orow = od + (size_t)(rb + HG_POS(4 * g)) * 512 + 32 * w + n;
#pragma unroll
            for (int mbc = 0; mbc < 2; ++mbc)
#pragma unroll
                for (int j = 0; j < 4; ++j) { bf16_t* q_ = orow + (16 * mbc + j) * st; q_[0] = f2bf(o[mbc][0][j]); q_[16] = f2bf(o[mbc][1][j]); }
        }
        LDS_BARRIER();
    }
    asm volatile("s_waitcnt vmcnt(0)" ::: "memory");
    __syncthreads();
#undef HG_RB
#undef HG_POS
#undef HG_DMA
}

__device__ __forceinline__ void attn_item(const Params& p, int item, LAS unsigned char* lds) {
    const int t = tid_(), lane = t & 63, w = __builtin_amdgcn_readfirstlane(t >> 6), c32 = lane & 31, hh = lane >> 5;
    const int qb = item & 15, kvh = (item >> 4) & 1, b = item >> 5, hq = kvh * 4 + (w >> 1), qh = w & 1, t0 = qb * 128 + 64 * qh;
    const bf16_t* kv = WSP(const bf16_t, OFF_KV); const bf16_t* qat = WSP(const bf16_t, OFF_QAT); bf16_t* yat = WSP(bf16_t, OFF_QAT);
    constexpr int KS = 0, VTO = 55296, VSTR = 784;
    constexpr float LOG2E = 1.4426950408889634f;
    bf16x8 Qf[2][4];
#pragma unroll
    for (int nb = 0; nb < 2; ++nb)
#pragma unroll
        for (int ds = 0; ds < 4; ++ds) Qf[nb][ds] = *(const bf16x8*)(qat + (size_t)(b * 2048 + t0 + 32 * nb + c32) * 512 + hq * 64 + 16 * ds + 8 * hh);
    f32x16 O[2][2];
#pragma unroll
    for (int a = 0; a < 2; ++a)
#pragma unroll
        for (int d = 0; d < 2; ++d)
#pragma unroll
            for (int r = 0; r < 16; ++r) O[a][d][r] = 0.f;
    float mrun[2], lrun[2];
    mrun[0] = mrun[1] = p.sinks[hq] * LOG2E; lrun[0] = lrun[1] = hh == 0 ? 1.f : 0.f;
    for (int stage = 0; stage < 2; ++stage) {
        const int kbase = stage == 0 ? 128 * (qb - 1) : 0, nkeys = stage == 0 ? 384 : 256;
        __syncthreads();
        {
            u32x4 kr[6], vr[6];
#pragma unroll
            for (int i = 0; i < 6; ++i) { const int idx = t + 512 * i; const int part = stage == 0 ? idx / 384 : idx >> 8, key = stage == 0 ? idx - part * 384 : idx & 255, tok = kbase + key;
                if (idx < nkeys * 8 && (stage == 1 || (tok >= 0 && tok < 2048))) { const size_t row = stage == 0 ? (size_t)(b * 2048 + tok) : (size_t)(MLAT + b * 256 + key);
                    kr[i] = *(const u32x4*)(kv + row * 256 + kvh * 64 + part * 8); vr[i] = *(const u32x4*)(kv + row * 256 + 128 + kvh * 64 + part * 8); }
                else { kr[i] = (u32x4){0u, 0u, 0u, 0u}; vr[i] = (u32x4){0u, 0u, 0u, 0u}; } }
#pragma unroll
            for (int i = 0; i < 6; ++i) { const int idx = t + 512 * i; const int part = stage == 0 ? idx / 384 : idx >> 8, key = stage == 0 ? idx - part * 384 : idx & 255;
                if (idx < nkeys * 8) { *(LAS u32x4*)(lds + KS + key * 144 + part * 16) = kr[i]; const u32x4 v = vr[i];
                    LAS bf16_t* vt = (LAS bf16_t*)(lds + VTO + (part * 8) * VSTR + key * 2);
                    vt[0] = (bf16_t)(v.x & 0xffffu); vt[392] = (bf16_t)(v.x >> 16); vt[784] = (bf16_t)(v.y & 0xffffu); vt[1176] = (bf16_t)(v.y >> 16);
                    vt[1568] = (bf16_t)(v.z & 0xffffu); vt[1960] = (bf16_t)(v.z >> 16); vt[2352] = (bf16_t)(v.w & 0xffffu); vt[2744] = (bf16_t)(v.w >> 16); } }
        }
        __syncthreads();
        const int tl0 = stage == 0 ? 2 * qh : 0, tl1 = stage == 0 ? 2 * qh + 10 : 8;
        for (int tl = tl0; tl < tl1; ++tl) {
            const int ks = kbase + 32 * tl;
            if (stage == 0 && (ks < 0 || ks >= 2048)) continue;
            bf16x8 Kf[4]; u32x4 Vf[2][2];
#pragma unroll
            for (int ds = 0; ds < 4; ++ds) Kf[ds] = *(const LAS bf16x8*)(lds + KS + (32 * tl + c32) * 144 + (16 * ds + 8 * hh) * 2);
#pragma unroll
            for (int md = 0; md < 2; ++md)
#pragma unroll
                for (int s = 0; s < 2; ++s) { const LAS unsigned char* vr = lds + VTO + (32 * md + c32) * VSTR + (32 * tl + 16 * s + 4 * hh) * 2;
                    const u32x2 lo = *(const LAS u32x2*)vr, hi = *(const LAS u32x2*)(vr + 16); Vf[md][s] = (u32x4){lo.x, lo.y, hi.x, hi.y}; }
#pragma unroll
            for (int nb = 0; nb < 2; ++nb) {
                if (stage == 0) { const int rel = tl - 2 * qh; if (rel < nb || rel > nb + 8) continue; }
                f32x16 sc;
#pragma unroll
                for (int r = 0; r < 16; ++r) sc[r] = 0.f;
#pragma unroll
                for (int ds = 0; ds < 4; ++ds) sc = __builtin_amdgcn_mfma_f32_32x32x16_bf16(Kf[ds], Qf[nb][ds], sc, 0, 0, 0);
                const int tq = t0 + 32 * nb + c32;
                float mt = -1e30f;
                const bool edge = stage == 0 && (tl - 2 * qh == nb || tl - 2 * qh == nb + 8);
#pragma unroll
                for (int r = 0; r < 16; ++r) { float v = sc[r];
                    if (edge) { const int dlt = tq - (ks + 8 * (r >> 2) + 4 * hh + (r & 3)); v = (dlt <= 128 && dlt >= -128) ? v : -1e30f; }
                    sc[r] = v; mt = fmaxf(mt, v); }
                mt = fmaxf(mt, __shfl_xor(mt, 32));
                const float mn = fmaxf(mrun[nb], mt), al = __builtin_amdgcn_exp2f(mrun[nb] - mn); mrun[nb] = mn;
                float ls = 0.f;
#pragma unroll
                for (int r = 0; r < 16; ++r) { const float pe = __builtin_amdgcn_exp2f(sc[r] - mn); sc[r] = pe; ls += pe; }
                lrun[nb] = lrun[nb] * al + ls;
                if (__builtin_amdgcn_ballot_w64(al != 1.f) != 0ull) {
#pragma unroll
                for (int md = 0; md < 2; ++md)
#pragma unroll
                    for (int r = 0; r < 16; ++r) O[nb][md][r] *= al;
                }
#pragma unroll
                for (int s = 0; s < 2; ++s) { u32x4 pw; pw.x = cvt_pk_bf16(sc[8 * s], sc[8 * s + 1]); pw.y = cvt_pk_bf16(sc[8 * s + 2], sc[8 * s + 3]); pw.z = cvt_pk_bf16(sc[8 * s + 4], sc[8 * s + 5]); pw.w = cvt_pk_bf16(sc[8 * s + 6], sc[8 * s + 7]);
                    const bf16x8 Pb = __builtin_bit_cast(bf16x8, pw);
#pragma unroll
                    for (int md = 0; md < 2; ++md) O[nb][md] = __builtin_amdgcn_mfma_f32_32x32x16_bf16(__builtin_bit_cast(bf16x8, Vf[md][s]), Pb, O[nb][md], 0, 0, 0); }
            }
        }
    }
#pragma unroll
    for (int nb = 0; nb < 2; ++nb) { const float lt = lrun[nb] + __shfl_xor(lrun[nb], 32), il = 1.f / lt; bf16_t* yr = yat + (size_t)(b * 2048 + t0 + 32 * nb + c32) * 512 + hq * 64;
#pragma unroll
        for (int md = 0; md < 2; ++md)
#pragma unroll
            for (int i = 0; i < 4; ++i) { u32x2 o; o.x = cvt_pk_bf16(O[nb][md][4 * i] * il, O[nb][md][4 * i + 1] * il); o.y = cvt_pk_bf16(O[nb][md][4 * i + 2] * il, O[nb][md][4 * i + 3] * il);
                *(u32x2*)(yr + 32 * md + 8 * i + 4 * hh) = o; } }
}

__device__ __forceinline__ void readout_phase(const Params& p) {
    const int tt = tid_(), lane = tt & 63, gw = blockIdx.x * 8 + (tt >> 6), ngw = gridDim.x * 8;
    const bf16_t* of = (const bf16_t*)((unsigned char*)p.out + OUT_OF); const bf16_t* ob = (const bf16_t*)((unsigned char*)p.out + OUT_OB); bf16_t* yh = WSP(bf16_t, OFF_GHG);
    const bf16_t* ghg = WSP(bf16_t, OFF_GHG);
    const f32x4 w0 = *(const f32x4*)(p.hgrn_norm_w + (lane & 15) * 8), w1 = *(const f32x4*)(p.hgrn_norm_w + (lane & 15) * 8 + 4);
    for (int r0 = gw; r0 < MLAT; r0 += 4 * ngw) {
        u32x4 a[4], bq[4], gg[4];
#pragma unroll
        for (int j = 0; j < 4; ++j) { const size_t o = (size_t)(r0 + j * ngw) * 512 + lane * 8; a[j] = __builtin_nontemporal_load((const u32x4*)(of + o)); bq[j] = __builtin_nontemporal_load((const u32x4*)(ob + o)); gg[j] = __builtin_nontemporal_load((const u32x4*)(ghg + o)); }
#pragma unroll
        for (int j = 0; j < 4; ++j) { const size_t o = (size_t)(r0 + j * ngw) * 512 + lane * 8;
            f32x4 s0 = {bf_lo(a[j].x) + bf_lo(bq[j].x), bf_hi(a[j].x) + bf_hi(bq[j].x), bf_lo(a[j].y) + bf_lo(bq[j].y), bf_hi(a[j].y) + bf_hi(bq[j].y)};
            f32x4 s1 = {bf_lo(a[j].z) + bf_lo(bq[j].z), bf_hi(a[j].z) + bf_hi(bq[j].z), bf_lo(a[j].w) + bf_lo(bq[j].w), bf_hi(a[j].w) + bf_hi(bq[j].w)};
            float ss = (s0[0] * s0[0] + s0[1] * s0[1]) + (s0[2] * s0[2] + s0[3] * s0[3]) + (s1[0] * s1[0] + s1[1] * s1[1]) + (s1[2] * s1[2] + s1[3] * s1[3]);
            ss += __shfl_xor(ss, 1); ss += __shfl_xor(ss, 2); ss += __shfl_xor(ss, 4); ss += __shfl_xor(ss, 8);
            const float rinv = rsqrtf(ss * (1.f / 128.f) + EPSN);
            const f32x4 g0 = {bf_lo(gg[j].x), bf_hi(gg[j].x), bf_lo(gg[j].y), bf_hi(gg[j].y)}, g1 = {bf_lo(gg[j].z), bf_hi(gg[j].z), bf_lo(gg[j].w), bf_hi(gg[j].w)};
            *(u32x4*)(yh + o) = pack8(s0 * rinv * w0 * g0, s1 * rinv * w1 * g1); }
    }
}

#define XB_TMO      128
#define XB_XCNT(j)  (256  + 64 * (j))
#define XB_XSUB(j)  (1280 + 64 * (j))
#define XB_XGEN(j)  (2304 + 64 * (j))
#define XB_TOP      3328
#define XB_TOPGEN   3392
#define XCD_BAR_WORDS 3456
#define XB_SPIN_CAP (1u << 18)
__device__ __forceinline__ unsigned xb_ld(unsigned* p)              { return __hip_atomic_load(p, __ATOMIC_RELAXED, __HIP_MEMORY_SCOPE_AGENT); }
__device__ __forceinline__ unsigned xb_add(unsigned* p, unsigned v) { return __hip_atomic_fetch_add(p, v, __ATOMIC_RELAXED, __HIP_MEMORY_SCOPE_AGENT); }
__device__ __forceinline__ unsigned xb_xcc_id() { return (unsigned)__builtin_amdgcn_s_getreg((3 << 11) | 20) & 0xFu; }
#define XB_SPIN(cond, bar) do { unsigned _sp = 0; while (cond) { __builtin_amdgcn_s_sleep(1); \
    if ((++_sp & 255u) == 0u) { if (xb_ld(&(bar)[XB_TMO])) break; if (_sp > XB_SPIN_CAP) { atomicAdd(&(bar)[XB_TMO], 1u); break; } } } } while (0)
struct XcdBarrier { unsigned* bar; unsigned x; volatile LAS unsigned* st; };
__device__ __forceinline__ XcdBarrier xcd_barrier_post(unsigned* bar, volatile LAS unsigned* st) {
    XcdBarrier b; b.bar = bar; b.x = xb_xcc_id(); b.st = st;
    if (threadIdx.x == 0) (void)xb_add(&bar[XB_XCNT(b.x)], 1u);
    return b;
}
__device__ __forceinline__ void xcd_barrier_complete(unsigned* bar, unsigned x, unsigned& nloc, unsigned& nx) {
    const unsigned G = gridDim.x * gridDim.y * gridDim.z;
    unsigned sum, cnt, mine, sp = 0u;
    for (;;) {
        sum = 0u; cnt = 0u; mine = 0u;
#pragma unroll
        for (unsigned j = 0; j < 16; ++j) { const unsigned c = xb_ld(&bar[XB_XCNT(j)]); sum += c; cnt += (c > 0u) ? 1u : 0u; mine = (j == x) ? c : mine; }
        if (sum == G) break;
        __builtin_amdgcn_s_sleep(1);
        if ((++sp & 255u) == 0u) { if (xb_ld(&bar[XB_TMO])) break; if (sp > XB_SPIN_CAP) { atomicAdd(&bar[XB_TMO], 1u); break; } }
    }
    nloc = mine > 0u ? mine : 1u; nx = cnt > 0u ? cnt : 1u;
}
__device__ __forceinline__ void xcd_barrier(const XcdBarrier& b) {
    asm volatile("s_waitcnt vmcnt(0)" ::: "memory");
    __syncthreads();
    if (threadIdx.x == 0) {
        unsigned* bar = b.bar;
        __builtin_amdgcn_s_waitcnt(0);
        unsigned nloc = b.st[0], nx = b.st[1];
        if (nloc == 0u) { xcd_barrier_complete(bar, b.x, nloc, nx); b.st[0] = nloc; b.st[1] = nx; }
        const unsigned old = xb_add(&bar[XB_XSUB(b.x)], 1u);
        const unsigned gen = old / nloc;
        if (old + 1u == (gen + 1u) * nloc) {
            __builtin_amdgcn_fence(__ATOMIC_RELEASE, "agent");
            asm volatile("s_waitcnt vmcnt(0)" ::: "memory");
            const unsigned og = xb_add(&bar[XB_TOP], 1u);
            const unsigned tg = og / nx;
            if (og + 1u == (tg + 1u) * nx) xb_add(&bar[XB_TOPGEN], 1u);
            else XB_SPIN(xb_ld(&bar[XB_TOPGEN]) == tg, bar);
            __builtin_amdgcn_fence(__ATOMIC_ACQUIRE, "agent");
            xb_add(&bar[XB_XGEN(b.x)], 1u);
            asm volatile("s_waitcnt vmcnt(0)" ::: "memory");
        } else {
            XB_SPIN(xb_ld(&bar[XB_XGEN(b.x)]) == gen, bar);
            __builtin_amdgcn_fence(__ATOMIC_ACQUIRE, "agent");
            asm volatile("s_waitcnt vmcnt(0)" ::: "memory");
        }
    }
    __syncthreads();
}

constexpr int N_PHASES = 10;
#ifndef PH_MASK
#define PH_MASK 0x3ff
#endif
#define PH_ON(n) ((PH_MASK >> (n)) & 1)
__global__ void __launch_bounds__(512, 2) mega(Params p, int ph_lo, int ph_hi) {
    extern __shared__ __attribute__((aligned(16))) unsigned char shm[];
    LAS unsigned char* lds = (LAS unsigned char*)shm;
    const int G0 = gridDim.x, c0 = blockIdx.x;
    volatile LAS unsigned* xst = (volatile LAS unsigned*)(lds + LDS_WORK);
    if (threadIdx.x == 0) { xst[0] = 0u; xst[1] = 0u; }
    __syncthreads();
    const XcdBarrier xb = xcd_barrier_post((unsigned*)(p.ws + OFF_BAR), xst);
    if (ph_hi > 1000) cg::this_grid().sync();
    for (int ph = ph_lo; ph < ph_hi; ++ph) {
        int G = G0, c = c0; asm volatile("" : "+s"(G), "+s"(c));
        if (ph > ph_lo) xcd_barrier(xb);
        for (int rep = 0; rep < (((PROBE_MASK >> ph) & 1) ? PROBE_N : 1); ++rep) {
        if (rep) xcd_barrier(xb);
        switch (ph) {
#if PH_ON(0)
        case 0: {
            for (int it = c; it < 97 + 336; it += G) {
                if (it < 96) mod_item(p, it, (LAS float*)lds);
                else if (it == 96) tables_item(p);
                else conv_item(p, it - 97, (LAS float*)lds);
            }
        } break;
#endif
#if PH_ON(1)
        case 1: norm_phase(p, p.x, p.ctx, MALL, p.norm_mix_w, 0, 1024, (bf16_t*)p.out); break;
#endif
#if PH_ON(2)
        case 2: {
            pg8::Gemm g{(const bf16_t*)p.out, WSP(const bf16_t, OFF_WIN), 1024}; SchedInA S{G, c};
            const float* tab = WSP(const float, OFF_TAB);
            EpiIn E{WSP(half_t, OFF_LF), WSP(bf16_t, OFF_INP), WSP(bf16_t, OFF_KV), WSP(bf16_t, OFF_QHG), WSP(bf16_t, OFF_GHG), WSP(bf16_t, OFF_QAT), WSP(bf16_t, OFF_GATES), tab + 2048, tab, tab + 1024, p.q_norm_w, p.k_norm_w};
            pg8::gemm_phase<EpiIn, SchedInA, true, true>(lds, g, S, E);
        } break;
#endif
#if PH_ON(3)
        case 3: {
            if (c < 64) { hgrn_item(p, c, lds); for (int it = 336 + c; it < 336 + 0; it += 64) conv_item(p, it, (LAS float*)lds); }
            else {
                const int cc = c - 64, GB = G - 64;
                { pg8::Gemm g{(const bf16_t*)p.out, WSP(const bf16_t, OFF_WIN), 1024}; SchedInB S{GB, cc};
                  const float* tab = WSP(const float, OFF_TAB);
                  EpiIn E{WSP(half_t, OFF_LF), WSP(bf16_t, OFF_INP), WSP(bf16_t, OFF_KV), WSP(bf16_t, OFF_QHG), WSP(bf16_t, OFF_GHG), WSP(bf16_t, OFF_QAT), WSP(bf16_t, OFF_GATES), tab + 2048, tab, tab + 1024, p.q_norm_w, p.k_norm_w};
                  pg8::gemm_phase<EpiIn, SchedInB, true, true>(lds, g, S, E); }
                for (int it = (cc + GB - 56) % GB; it < 256; it += GB) attn_item(p, it, lds);
                __syncthreads();
                for (int it = 336 + 0 + (cc + GB - 120) % GB; it < 992; it += GB) conv_item(p, it, (LAS float*)lds);
            }
        } break;
#endif
#if PH_ON(4)
        case 4: readout_phase(p); break;
#endif
#if PH_ON(5)
        case 5: {
            pg8::Gemm g{WSP(const bf16_t, OFF_GHG), WSP(const bf16_t, OFF_WB), 512}; SchedPair S{G, c};
            EpiBranch E{WSP(const bf16_t, OFF_GATES), WSP(bf16_t, OFF_MIXED)};
            pg8::gemm_phase<EpiBranch, SchedPair, true, true>(lds, g, S, E);
        } break;
#endif
#if PH_ON(6)
        case 6: {
            pg8::Gemm g{WSP(const bf16_t, OFF_MIXED), WSP(const bf16_t, OFF_WOUT), 1024}; SchedPlain S{64, 4, G, c};
            EpiRes E{p.x, WSP(const float, OFF_MOD) + 2048, p.out};
            pg8::gemm_phase<EpiRes, SchedPlain, false, true>(lds, g, S, E);
        } break;
#endif
#if PH_ON(7)
        case 7: norm_phase(p, p.out, nullptr, MLAT, p.norm_ffn_w, 3072, 4096, WSP(bf16_t, OFF_H2)); break;
#endif
#if PH_ON(8)
        case 8: {
            pg8::Gemm g{WSP(const bf16_t, OFF_H2), WSP(const bf16_t, OFF_WGU), 1024}; SchedPlain S{64, 22, G, c};
            EpiGU E{WSP(bf16_t, OFF_ACT)};
            pg8::gemm_phase<EpiGU, SchedPlain, true, true>(lds, g, S, E);
        } break;
#endif
#if PH_ON(9)
        case 9: {
            pg8::Gemm g{WSP(const bf16_t, OFF_ACT), WSP(const bf16_t, OFF_WDN), 2816}; SchedPlain S{64, 4, G, c};
            EpiRes E{p.out, WSP(const float, OFF_MOD) + 5120, p.out};
            pg8::gemm_phase<EpiRes, SchedPlain, false, true>(lds, g, S, E);
        } break;
#endif
        }
        }
    }
}

extern "C" void kernel_launch(void* const* d_in, const int* in_sizes, int n_in, void* d_out, int out_size, void* d_ws, size_t ws_size, hipStream_t stream) {
    static int grid = 0;
    if (grid == 0) {
        if (n_in != 20 || ws_size < WS_END) { fprintf(stderr, "kernel_launch: unexpected n_in %d / ws_size %zu (need %zu)\n", n_in, ws_size, (size_t)WS_END); grid = -1; return; }
        int dev = 0, cus = 0, per_cu = 0;
        hipGetDevice(&dev); hipDeviceGetAttribute(&cus, hipDeviceAttributeMultiprocessorCount, dev);
        if (hipFuncSetAttribute((const void*)mega, hipFuncAttributeMaxDynamicSharedMemorySize, LDS_BYTES) != hipSuccess) { fprintf(stderr, "kernel_launch: hipFuncSetAttribute failed\n"); grid = -1; return; }
        if (hipOccupancyMaxActiveBlocksPerMultiprocessor(&per_cu, (const void*)mega, 512, LDS_BYTES) != hipSuccess || per_cu < 1) { fprintf(stderr, "kernel_launch: occupancy query gave %d\n", per_cu); per_cu = 1; }
        (void)hipGetLastError();
        grid = cus * 1;
    }
    if (grid < 0) return;
    Params p{};
    const float** pp = (const float**)&p;
    for (int i = 0; i < 20; ++i) pp[i] = (const float*)d_in[i];
    p.out = (float*)d_out; p.ws = (unsigned char*)d_ws;
#if COOP
    if (hipMemsetAsync((unsigned char*)d_ws + OFF_BAR, 0, BAR_BYTES, stream) != hipSuccess) { fprintf(stderr, "kernel_launch: memset of the barrier words failed\n"); return; }
    int lo = 0, hi = N_PHASES; void* args[] = {&p, &lo, &hi};
    hipError_t e = hipLaunchCooperativeKernel((const void*)mega, dim3(grid), dim3(512), args, LDS_BYTES, stream);
    if (e != hipSuccess) fprintf(stderr, "cooperative launch failed: %s (grid %d)\n", hipGetErrorString(e), grid);
#else
    for (int ph = 0; ph < N_PHASES; ++ph) hipLaunchKernelGGL(mega, dim3(grid), dim3(512), LDS_BYTES, stream, p, ph, ph + 1);
#endif
}
```
